# Optimizing an MI355X kernel written in HIP

```python
import math
import jax, jax.numpy as jnp
from jax import lax
import numpy as np


D_MODEL = 1024
BATCH = 2
SEQ = 16384
DEPTH = 2

N_A_LAYERS = DEPTH // 2
N_B_LAYERS = DEPTH - N_A_LAYERS
D_FF = 2816
GM_HALF = D_MODEL
GM_GROUPS = 8
GM_GROUP_CH = GM_HALF // GM_GROUPS
CHUNK = 128
DA_HEADS = 8
DA_HEAD_DIM = D_MODEL // (2 * DA_HEADS)
DA_WIDTH = DA_HEADS * 2 * DA_HEAD_DIM
Q_BLOCK = 128
RMS_EPS = 1e-6
LN_EPS = 1e-5

kernel_name = "yoco_gmlp_diffattn_macaron"


def rms_norm(x, g):
    xf = x.astype(jnp.float32)
    y = xf * lax.rsqrt(jnp.mean(xf * xf, axis=-1, keepdims=True) + RMS_EPS)
    return (y * g.astype(jnp.float32)).astype(x.dtype)


def swiglu(h, w_gate, w_up, w_down):
    return (jax.nn.silu(h @ w_gate) * (h @ w_up)) @ w_down


def lambda_init_fn(layer_idx):
    return 0.8 - 0.6 * math.exp(-0.3 * layer_idx)


def chunked_gmlp(h, w_in, ln_g, ln_b, w_s, b_s, w_out):
    B, S, _ = h.shape
    z = jax.nn.gelu(h @ w_in, approximate=False)
    u, v = z[..., :GM_HALF], z[..., GM_HALF:]
    vf = v.astype(jnp.float32)
    mu = jnp.mean(vf, axis=-1, keepdims=True)
    var = jnp.mean(jnp.square(vf - mu), axis=-1, keepdims=True)
    v = ((vf - mu) * lax.rsqrt(var + LN_EPS) * ln_g.astype(jnp.float32)
         + ln_b.astype(jnp.float32)).astype(h.dtype)
    causal = jnp.tril(jnp.ones((CHUNK, CHUNK), dtype=bool))
    ws = jnp.where(causal[None], w_s, jnp.zeros_like(w_s))
    vc = v.reshape(B, S // CHUNK, CHUNK, GM_GROUPS, GM_GROUP_CH)
    sv = jnp.einsum('gts,bnsgc->bntgc', ws, vc) + b_s.T[None, None, :, :, None]
    return (u * sv.reshape(B, S, GM_HALF)) @ w_out


def shared_kv(x, g, w_k, w_v):
    h = rms_norm(x, g)
    B, S, _ = h.shape
    k = (h @ w_k).reshape(B, S, DA_HEADS, 2, DA_HEAD_DIM).transpose(0, 2, 3, 1, 4)
    v = (h @ w_v).reshape(B, S, DA_HEADS, 2 * DA_HEAD_DIM).transpose(0, 2, 1, 3)
    return k, v


def diff_attention(h, k_sh, v_sh, w_q, lam_q1, lam_k1, lam_q2, lam_k2, subln_g, w_o, lambda_init):
    B, S, _ = h.shape
    nb = S // Q_BLOCK
    q = (h @ w_q).reshape(B, nb, Q_BLOCK, DA_HEADS, 2, DA_HEAD_DIM)
    q_blocks = q.transpose(1, 0, 3, 4, 2, 5)
    lam = (jnp.exp(jnp.sum(lam_q1.astype(jnp.float32) * lam_k1.astype(jnp.float32)))
           - jnp.exp(jnp.sum(lam_q2.astype(jnp.float32) * lam_k2.astype(jnp.float32)))
           + lambda_init)
    slopes = jnp.exp2(-8.0 * (jnp.arange(DA_HEADS, dtype=jnp.float32) + 1.0) / DA_HEADS)
    key_pos = jnp.arange(S, dtype=jnp.int32)
    scale = DA_HEAD_DIM ** -0.5

    def one_block(args):
        qb, start = args
        s = jnp.einsum('bhiqd,bhikd->bhiqk', qb, k_sh).astype(jnp.float32) * scale
        dist = (start + jnp.arange(Q_BLOCK, dtype=jnp.int32))[:, None] - key_pos[None, :]
        s = s - slopes[None, :, None, None, None] * dist.astype(jnp.float32)
        s = jnp.where(dist >= 0, s, -jnp.inf)
        p = jax.nn.softmax(s, axis=-1)
        a = p[:, :, 0] - lam * p[:, :, 1]
        return jnp.einsum('bhqk,bhkd->bhqd', a.astype(v_sh.dtype), v_sh)

    starts = jnp.arange(nb, dtype=jnp.int32) * Q_BLOCK
    o = lax.map(one_block, (q_blocks, starts))
    o = o.transpose(1, 0, 3, 2, 4).reshape(B, S, DA_HEADS, 2 * DA_HEAD_DIM)
    o = rms_norm(o, subln_g) * (1.0 - lambda_init)
    return o.reshape(B, S, DA_WIDTH) @ w_o


def setup_inputs(seed: int = 0) -> dict:
    key = jax.random.key(seed)
    ks = iter(jax.random.split(key, 40))

    def nrm(shape, scale):
        return jax.random.normal(next(ks), shape, jnp.float32) * scale

    def gain(shape):
        return 1.0 + nrm(shape, 0.02)

    D, F = D_MODEL, D_FF
    return {
        "x": nrm((BATCH, SEQ, D), 1.0),
        "ffn_norm1_g": gain((DEPTH, D)),
        "ffn1_w_gate": nrm((DEPTH, D, F), D ** -0.5),
        "ffn1_w_up": nrm((DEPTH, D, F), D ** -0.5),
        "ffn1_w_down": nrm((DEPTH, F, D), F ** -0.5),
        "mix_norm_g": gain((DEPTH, D)),
        "ffn_norm2_g": gain((DEPTH, D)),
        "ffn2_w_gate": nrm((DEPTH, D, F), D ** -0.5),
        "ffn2_w_up": nrm((DEPTH, D, F), D ** -0.5),
        "ffn2_w_down": nrm((DEPTH, F, D), F ** -0.5),
        "gm_w_in": nrm((N_A_LAYERS, D, 2 * GM_HALF), D ** -0.5),
        "gm_ln_g": gain((N_A_LAYERS, GM_HALF)),
        "gm_ln_b": nrm((N_A_LAYERS, GM_HALF), 0.02),
        "gm_w_s": nrm((N_A_LAYERS, GM_GROUPS, CHUNK, CHUNK), CHUNK ** -0.5),
        "gm_b_s": gain((N_A_LAYERS, GM_GROUPS, CHUNK)),
        "gm_w_out": nrm((N_A_LAYERS, GM_HALF, D), GM_HALF ** -0.5),
        "kv_norm_g": gain((D,)),
        "w_k": nrm((D, DA_WIDTH), D ** -0.5),
        "w_v": nrm((D, DA_WIDTH), D ** -0.5),
        "da_w_q": nrm((N_B_LAYERS, D, DA_WIDTH), D ** -0.5),
        "da_lam_q1": nrm((N_B_LAYERS, DA_HEAD_DIM), 0.1),
        "da_lam_k1": nrm((N_B_LAYERS, DA_HEAD_DIM), 0.1),
        "da_lam_q2": nrm((N_B_LAYERS, DA_HEAD_DIM), 0.1),
        "da_lam_k2": nrm((N_B_LAYERS, DA_HEAD_DIM), 0.1),
        "da_subln_g": gain((N_B_LAYERS, 2 * DA_HEAD_DIM)),
        "da_w_o": nrm((N_B_LAYERS, DA_WIDTH, D), DA_WIDTH ** -0.5),
        "final_norm_g": gain((D,)),
    }


def reference(x, ffn_norm1_g, ffn1_w_gate, ffn1_w_up, ffn1_w_down, mix_norm_g,
              ffn_norm2_g, ffn2_w_gate, ffn2_w_up, ffn2_w_down,
              gm_w_in, gm_ln_g, gm_ln_b, gm_w_s, gm_b_s, gm_w_out,
              kv_norm_g, w_k, w_v,
              da_w_q, da_lam_q1, da_lam_k1, da_lam_q2, da_lam_k2, da_subln_g, da_w_o,
              final_norm_g):
    k_sh = None
    v_sh = None
    for l in range(DEPTH):
        if l == N_A_LAYERS:
            k_sh, v_sh = shared_kv(x, kv_norm_g, w_k, w_v)
        x = x + 0.5 * swiglu(rms_norm(x, ffn_norm1_g[l]), ffn1_w_gate[l], ffn1_w_up[l], ffn1_w_down[l])
        h = rms_norm(x, mix_norm_g[l])
        if l < N_A_LAYERS:
            x = x + chunked_gmlp(h, gm_w_in[l], gm_ln_g[l], gm_ln_b[l], gm_w_s[l], gm_b_s[l], gm_w_out[l])
        else:
            j = l - N_A_LAYERS
            x = x + diff_attention(h, k_sh, v_sh, da_w_q[j], da_lam_q1[j], da_lam_k1[j],
                                   da_lam_q2[j], da_lam_k2[j], da_subln_g[j], da_w_o[j],
                                   lambda_init_fn(l))
        x = x + 0.5 * swiglu(rms_norm(x, ffn_norm2_g[l]), ffn2_w_gate[l], ffn2_w_up[l], ffn2_w_down[l])
    return rms_norm(x, final_norm_g)
```

```cpp
#include <hip/hip_runtime.h>
#include <hip/hip_cooperative_groups.h>
#include <cstdio>
#include <cstdint>
#include <cmath>
namespace cg = cooperative_groups;
namespace pg8 {
#define PG8_LAS __attribute__((address_space(3)))
typedef unsigned short bf16_t;
typedef short bf16x8 __attribute__((ext_vector_type(8)));
typedef float f32x4 __attribute__((ext_vector_type(4)));
typedef unsigned u32x4 __attribute__((ext_vector_type(4)));
constexpr int BM = 256, BK = 64, HALF = 128, HTB = HALF * BK * 2  , STAGE_BYTES = 8 * HTB, NXCD = 8, WGM = 8;

__host__ __device__ __forceinline__ int lds_byte(int r, int c) { const int st = (r >> 4) * 2 + (c >> 5), rr = r & 15, cc = c & 31, ob = rr * 64 + cc * 2; return st * 1024 + (ob ^ (((ob >> 9) & 1) << 5)); }
__host__ __device__ __forceinline__ void stage_rc(int b, int& R, int& C) { const int st = b / 1024, sb = b % 1024, swz = sb ^ (((sb >> 9) & 1) << 5); R = (st >> 1) * 16 + swz / 64; C = (st & 1) * 32 + (swz % 64) / 2; }
__host__ __device__ __forceinline__ int perm32(int rho) { const int n = rho >> 4, i = rho & 15; return 8 * (i >> 2) + 4 * n + (i & 3); }

struct Unit { int pm, pn; };
struct Gemm { const bf16_t* A; const bf16_t* Bt; int M, N, K; };

struct StaticOrder {
    int nM, nN, nwg, G, c;
    __host__ __device__ void init(int M, int N, int G_, int c_) { nM = M / BM; nN = N / BM; nwg = nM * nN; G = G_; c = c_; }
    __host__ __device__ bool next(int i, Unit& u) const {
        const long L = (long)i * G + c; if (L >= nwg) return false;
        int wgid = (int)L; { const int q = nwg / NXCD, r = nwg % NXCD, xcd = wgid % NXCD, off = wgid / NXCD; wgid = (xcd < r ? xcd * (q + 1) : r * (q + 1) + (xcd - r) * q) + off; }
        const int nig = WGM * nN, gid = wgid / nig, fm = gid * WGM, gsz = (nM - fm) < WGM ? (nM - fm) : WGM;
        u.pm = fm + ((wgid % nig) % gsz); u.pn = (wgid % nig) / gsz; return true;
    }
    __device__ __forceinline__ void a_ready(const Unit&) const {}
    __device__ __forceinline__ void done(const Unit&) const {}
};

__device__ __forceinline__ unsigned cvt_pk_bf16(float lo, float hi) { unsigned r; asm volatile("v_cvt_pk_bf16_f32 %0, %1, %2" : "=v"(r) : "v"(lo), "v"(hi)); return r; }
typedef float f32x2 __attribute__((ext_vector_type(2)));
__device__ __forceinline__ f32x2 gelu_pk(f32x2 v) {
    const f32x2 av = __builtin_elementwise_abs(v), d = av * 0.2316418882f + 1.0f;
    f32x2 t; t.x = __builtin_amdgcn_rcpf(d.x); t.y = __builtin_amdgcn_rcpf(d.y);
    f32x2 q = t * 0.5307027145f + (-0.7265760135f); q = q * t + 0.7107068705f; q = q * t + (-0.142248368f); q = q * t + 0.127414796f; q = q * t;
    const f32x2 s = (v * v) * (-0.72134752044f);
    f32x2 e; e.x = __builtin_amdgcn_exp2f(s.x); e.y = __builtin_amdgcn_exp2f(s.y);
    const f32x2 m = v * (q * e), r = v - m;
    f32x2 o; o.x = v.x < 0.f ? m.x : r.x; o.y = v.y < 0.f ? m.y : r.y; return o;
}
__device__ __forceinline__ float rstd_row(const float* ssq, int row) { return __builtin_amdgcn_rsqf(ssq[row] * (1.0f / 1024.0f) + 1e-6f); }

__device__ __forceinline__ void rstd8(const float* ssq, int row0, float cs, float (&rs)[8]) {
    float v[8];
#pragma unroll
    for (int i = 0; i < 8; ++i) v[i] = ssq[row0 + (i >> 2) * HALF + (i & 3) * 16];
#pragma unroll
    for (int i = 0; i < 8; ++i) rs[i] = __builtin_amdgcn_rsqf(v[i] * (1.0f / 1024.0f) + 1e-6f) * cs;
}
struct EpiSwiGLU {
    static constexpr bool PERM = true, AFTER_DRAIN = false;
    bf16_t* O; const float* ssq;
    __device__ __forceinline__ void operator()(const f32x4 (&acc)[2][2][4][2], const Unit& u, int wr, int wc, int fr, int fq) const {
        const int row0 = u.pm * BM + wr * 64 + fr, col0 = u.pn * HALF + wc * 32 + 8 * fq;
        float rs8[8]; rstd8(ssq, row0, 1.0f, rs8);
#pragma unroll
        for (int ai = 0; ai < 2; ++ai)
#pragma unroll
            for (int m = 0; m < 4; ++m) { const int row = row0 + ai * HALF + m * 16; const float rs = rs8[ai * 4 + m];
                const f32x4 g0 = acc[ai][0][m][0] * rs, g1 = acc[ai][0][m][1] * rs, u0 = acc[ai][1][m][0] * rs, u1 = acc[ai][1][m][1] * rs;
                const f32x4 a0 = g0 * -1.4426950408889634f, a1 = g1 * -1.4426950408889634f;
                f32x4 e0, e1, r0, r1;
#pragma unroll
                for (int j = 0; j < 4; ++j) { e0[j] = __builtin_amdgcn_exp2f(a0[j]); e1[j] = __builtin_amdgcn_exp2f(a1[j]); }
                const f32x4 d0 = e0 + 1.0f, d1 = e1 + 1.0f;
#pragma unroll
                for (int j = 0; j < 4; ++j) { r0[j] = __builtin_amdgcn_rcpf(d0[j]); r1[j] = __builtin_amdgcn_rcpf(d1[j]); }
                const f32x4 h0 = (g0 * u0) * r0, h1 = (g1 * u1) * r1;
                u32x4 wv; wv.x = cvt_pk_bf16(h0[0], h0[1]); wv.y = cvt_pk_bf16(h0[2], h0[3]); wv.z = cvt_pk_bf16(h1[0], h1[1]); wv.w = cvt_pk_bf16(h1[2], h1[3]);
                *(u32x4*)(O + (size_t)row * 2816 + col0) = wv; }
    }
};
struct EpiResid {
    static constexpr bool PERM = true, AFTER_DRAIN = false;
    const float* Xin; bf16_t* XH; bf16_t* XL; float* ssq_out; float coef;
    __device__ __forceinline__ void operator()(const f32x4 (&acc)[2][2][4][2], const Unit& u, int wr, int wc, int fr, int fq) const {
        const int row0 = u.pm * BM + wr * 64 + fr, col0 = u.pn * BM + wc * 32 + 8 * fq;
        const char* xin = (const char*)Xin; char* xh = (char*)XH; char* xl = (char*)XL;
        const bool f32in = Xin != nullptr;
#pragma unroll
        for (int ap = 0; ap < 4; ++ap) { const int ai = ap >> 1, mb = 2 * (ap & 1);
            u32x4 pre[2][2][2];
#pragma unroll
            for (int mm = 0; mm < 2; ++mm) { const unsigned r_ = (unsigned)(row0 + ai * HALF + (mb + mm) * 16);
#pragma unroll
                for (int bj = 0; bj < 2; ++bj) {
                    if (f32in) { const unsigned off = (r_ * 1024u + (unsigned)col0) * 4u + bj * (HALF * 4);
                        pre[mm][bj][0] = __builtin_nontemporal_load((const u32x4*)(xin + off)); pre[mm][bj][1] = __builtin_nontemporal_load((const u32x4*)(xin + off + 16)); }
                    else { pre[mm][bj][0] = *(const u32x4*)(xh + (r_ * 1024u + (unsigned)col0) * 2u + bj * (HALF * 2)); pre[mm][bj][1] = *(const u32x4*)(xl + (r_ * 2048u + (unsigned)col0) * 2u + bj * (HALF * 2)); } } }
#pragma unroll
            for (int mm = 0; mm < 2; ++mm) { const int m = mb + mm; const int row = row0 + ai * HALF + m * 16; float ss = 0.f;
#pragma unroll
                for (int bj = 0; bj < 2; ++bj) { float a[8];
                    if (f32in) {
#pragma unroll
                        for (int e = 0; e < 4; ++e) { a[e] = __uint_as_float(pre[mm][bj][0][e]); a[4 + e] = __uint_as_float(pre[mm][bj][1][e]); } }
                    else {
#pragma unroll
                        for (int e = 0; e < 4; ++e) { const unsigned hw = pre[mm][bj][0][e], lw = pre[mm][bj][1][e];
                            a[2 * e] = __uint_as_float(hw << 16) + __uint_as_float(lw << 16); a[2 * e + 1] = __uint_as_float(hw & 0xffff0000u) + __uint_as_float(lw & 0xffff0000u); } }
#pragma unroll
                    for (int e = 0; e < 4; ++e) { a[e] += acc[ai][bj][m][0][e] * coef; a[4 + e] += acc[ai][bj][m][1][e] * coef; }
                    u32x4 hv, lv;
#pragma unroll
                    for (int e = 0; e < 4; ++e) { ss += a[2 * e] * a[2 * e] + a[2 * e + 1] * a[2 * e + 1];
                        const unsigned hw = cvt_pk_bf16(a[2 * e], a[2 * e + 1]); hv[e] = hw;
                        lv[e] = cvt_pk_bf16(a[2 * e] - __uint_as_float(hw << 16), a[2 * e + 1] - __uint_as_float(hw & 0xffff0000u)); }
                    *(u32x4*)(xh + ((unsigned)row * 1024u + (unsigned)col0) * 2u + bj * (HALF * 2)) = hv;
                    *(u32x4*)(xl + ((unsigned)row * 2048u + (unsigned)col0) * 2u + bj * (HALF * 2)) = lv; }
                ss += __shfl_xor(ss, 16); ss += __shfl_xor(ss, 32);
                if (fq == 0) atomicAdd(ssq_out + row, ss); }
        }
    }
};
struct EpiGeluZ {
    static constexpr bool PERM = true, AFTER_DRAIN = false;
    bf16_t* Z; const float* ssq; float* vsum; float* vsq;
    __device__ __forceinline__ void operator()(const f32x4 (&acc)[2][2][4][2], const Unit& u, int wr, int wc, int fr, int fq) const {
        const int row0 = u.pm * BM + wr * 64 + fr, col0 = u.pn * BM + wc * 32 + 8 * fq; const bool isv = u.pn >= 4;
        float rs8[8]; rstd8(ssq, row0, 1.0f, rs8);
#pragma unroll
        for (int ai = 0; ai < 2; ++ai)
#pragma unroll
            for (int m = 0; m < 4; ++m) { const int row = row0 + ai * HALF + m * 16; const float rs = rs8[ai * 4 + m]; float s1 = 0.f, s2 = 0.f;
                bf16_t* zr = Z + (size_t)row * 2048 + col0;
#pragma unroll
                for (int bj = 0; bj < 2; ++bj) {
                    f32x4 v[2] = {acc[ai][bj][m][0] * rs, acc[ai][bj][m][1] * rs}, t[2], q[2], e[2], o[2];
#pragma unroll
                    for (int h = 0; h < 2; ++h) { const f32x4 d = __builtin_elementwise_abs(v[h]) * 0.2316418882f + 1.0f;
#pragma unroll
                        for (int j = 0; j < 4; ++j) t[h][j] = __builtin_amdgcn_rcpf(d[j]); }
#pragma unroll
                    for (int h = 0; h < 2; ++h) { f32x4 p_ = t[h] * 0.5307027145f + (-0.7265760135f); p_ = p_ * t[h] + 0.7107068705f; p_ = p_ * t[h] + (-0.142248368f); p_ = p_ * t[h] + 0.127414796f; q[h] = p_ * t[h]; }
#pragma unroll
                    for (int h = 0; h < 2; ++h) { const f32x4 sq = (v[h] * v[h]) * (-0.72134752044f);
#pragma unroll
                        for (int j = 0; j < 4; ++j) e[h][j] = __builtin_amdgcn_exp2f(sq[j]); }
#pragma unroll
                    for (int h = 0; h < 2; ++h) { const f32x4 mm_ = v[h] * (q[h] * e[h]), rr_ = v[h] - mm_;
#pragma unroll
                        for (int j = 0; j < 4; ++j) o[h][j] = v[h][j] < 0.f ? mm_[j] : rr_[j]; }
#pragma unroll
                    for (int h = 0; h < 2; ++h) { s1 += (o[h][0] + o[h][1]) + (o[h][2] + o[h][3]); s2 += (o[h][0] * o[h][0] + o[h][1] * o[h][1]) + (o[h][2] * o[h][2] + o[h][3] * o[h][3]); }
                    u32x4 w; w.x = cvt_pk_bf16(o[0][0], o[0][1]); w.y = cvt_pk_bf16(o[0][2], o[0][3]); w.z = cvt_pk_bf16(o[1][0], o[1][1]); w.w = cvt_pk_bf16(o[1][2], o[1][3]);
                    *(u32x4*)(zr + bj * HALF) = w; }
                if (isv) { s1 += __shfl_xor(s1, 16); s1 += __shfl_xor(s1, 32); s2 += __shfl_xor(s2, 16); s2 += __shfl_xor(s2, 32);
                    if (fq == 0) { atomicAdd(vsum + row, s1); atomicAdd(vsq + row, s2); } } }
    }
};
struct EpiScale {
    static constexpr bool PERM = true, AFTER_DRAIN = false;
    bf16_t* O; const float* ssq; float cs;
    __device__ __forceinline__ void operator()(const f32x4 (&acc)[2][2][4][2], const Unit& u, int wr, int wc, int fr, int fq) const {
        const int row0 = u.pm * BM + wr * 64 + fr, col0 = u.pn * BM + wc * 32 + 8 * fq;
        float rs8[8]; rstd8(ssq, row0, cs, rs8);
#pragma unroll
        for (int ai = 0; ai < 2; ++ai)
#pragma unroll
            for (int m = 0; m < 4; ++m) { const int row = row0 + ai * HALF + m * 16; const float rs = rs8[ai * 4 + m];
                bf16_t* orow = O + (size_t)row * 1024 + col0;
#pragma unroll
                for (int bj = 0; bj < 2; ++bj) { const f32x4 v0 = acc[ai][bj][m][0] * rs, v1 = acc[ai][bj][m][1] * rs;
                    u32x4 w; w.x = cvt_pk_bf16(v0[0], v0[1]); w.y = cvt_pk_bf16(v0[2], v0[3]); w.z = cvt_pk_bf16(v1[0], v1[1]); w.w = cvt_pk_bf16(v1[2], v1[3]);
                    *(u32x4*)(orow + bj * HALF) = w; } }
    }
};
struct EpiScaleCol {
    static constexpr bool PERM = true, AFTER_DRAIN = false;
    bf16_t* O; const float* ssq; int ldc;
    __device__ __forceinline__ void operator()(const f32x4 (&acc)[2][2][4][2], const Unit& u, int wr, int wc, int fr, int fq) const {
        const int row0 = u.pm * BM + wr * 64 + fr, col0 = u.pn * BM + wc * 32 + 8 * fq;
        f32x4 rs[2][2];
#pragma unroll
        for (int bj = 0; bj < 2; ++bj)
#pragma unroll
            for (int n = 0; n < 2; ++n) { const f32x4 s = *(const f32x4*)(ssq + col0 + bj * HALF + 4 * n);
#pragma unroll
                for (int j = 0; j < 4; ++j) rs[bj][n][j] = __builtin_amdgcn_rsqf(s[j] * (1.0f / 1024.0f) + 1e-6f); }
#pragma unroll
        for (int ai = 0; ai < 2; ++ai)
#pragma unroll
            for (int m = 0; m < 4; ++m) { const int row = row0 + ai * HALF + m * 16; bf16_t* orow = O + (size_t)row * ldc + col0;
#pragma unroll
                for (int bj = 0; bj < 2; ++bj) { const f32x4 v0 = acc[ai][bj][m][0] * rs[bj][0], v1 = acc[ai][bj][m][1] * rs[bj][1];
                    u32x4 w; w.x = cvt_pk_bf16(v0[0], v0[1]); w.y = cvt_pk_bf16(v0[2], v0[3]); w.z = cvt_pk_bf16(v1[0], v1[1]); w.w = cvt_pk_bf16(v1[2], v1[3]);
                    *(u32x4*)(orow + bj * HALF) = w; } }
    }
};
template <class Epi, class Sched, bool ALIGN_EPI = false, bool SP2 = false>
__device__ __forceinline__ void gemm_phase(PG8_LAS unsigned char* lds, const Gemm g, const Sched& S, const Epi& E) {
    int tid_l = threadIdx.x; asm volatile("" : "+v"(tid_l));
    const int tid = tid_l, wid = __builtin_amdgcn_readfirstlane(tid >> 6), lane = tid & 63, wr = wid >> 2, wc = wid & 3, fr = lane & 15, fq = lane >> 4;
    const int K = g.K, nt = K / BK;
    unsigned voffA[2], voffB[2];
#pragma unroll
    for (int i = 0; i < 2; ++i) { int R, C; stage_rc(tid * 16 + i * 8192, R, C); const int Rb = Epi::PERM ? ((R & ~31) + perm32(R & 31)) : R;
        voffA[i] = (unsigned)(R * K + C) * 2u; voffB[i] = (unsigned)(Rb * K + C) * 2u; }
    const size_t kstep = (size_t)(BK * 2);
    const size_t hstep = (size_t)HALF * K * 2;
    const size_t tstep = 2 * hstep;
    const unsigned ldsw = (unsigned)wid * 1024u;
    const int aoff = lds_byte(wr * 64 + fr, fq * 8), boff = lds_byte(wc * 32 + fr, fq * 8);
#define PG8_SA(b, h) (((b) * 2 + (h)) * HTB)
#define PG8_SB(b, h) ((4 + (b) * 2 + (h)) * HTB)
#define PG8_STAGE(bufoff, gbase, voff) do { _Pragma("unroll") for (int _i = 0; _i < 2; ++_i) \
        __builtin_amdgcn_global_load_lds((const unsigned*)((const char*)(gbase) + (voff)[_i]), (PG8_LAS unsigned*)(lds + (bufoff) + ldsw + _i * 8192), 16, 0, 0); } while (0)
#define PG8_LDA(dst, b, h) do { _Pragma("unroll") for (int m = 0; m < 4; ++m) _Pragma("unroll") for (int k = 0; k < 2; ++k) dst[m][k] = *(const PG8_LAS bf16x8*)(lds + PG8_SA(b, h) + aoff + m * 2048 + k * 1024); } while (0)
#define PG8_LDB(dst, b, h) do { _Pragma("unroll") for (int n = 0; n < 2; ++n) _Pragma("unroll") for (int k = 0; k < 2; ++k) dst[n][k] = *(const PG8_LAS bf16x8*)(lds + PG8_SB(b, h) + boff + n * 2048 + k * 1024); } while (0)
#define PG8_MMA(ai, bj, At, Bt) do { __builtin_amdgcn_s_setprio(1); _Pragma("unroll") for (int m = 0; m < 4; ++m) _Pragma("unroll") for (int n = 0; n < 2; ++n) _Pragma("unroll") for (int k = 0; k < 2; ++k) \
        acc[ai][bj][m][n] = __builtin_amdgcn_mfma_f32_16x16x32_bf16(Bt[n][k], At[m][k], acc[ai][bj][m][n], 0, 0, 0); __builtin_amdgcn_s_setprio(0); } while (0)
#define PG8_WAIT_V(n) asm volatile("s_waitcnt vmcnt(" #n ")" ::: "memory")
#define PG8_WAIT_L(n) asm volatile("s_waitcnt lgkmcnt(" #n ")" ::: "memory")
#define PG8_BAR __builtin_amdgcn_s_barrier()
#define PG8_SCHED __builtin_amdgcn_sched_barrier(0)
    Unit cur, nxt; int ui = 0;
    if (!S.next(0, cur)) return;
    f32x4 acc[2][2][4][2];
#pragma unroll
    for (int a = 0; a < 2; ++a)
#pragma unroll
        for (int b = 0; b < 2; ++b)
#pragma unroll
            for (int m = 0; m < 4; ++m)
#pragma unroll
                for (int n = 0; n < 2; ++n) acc[a][b][m][n] = (f32x4){0.f, 0.f, 0.f, 0.f};
    bf16x8 At[4][2], B0[2][2], B1[2][2];
    const char* cA = (const char*)g.A + (size_t)cur.pm * tstep; const char* cB = (const char*)g.Bt + (size_t)cur.pn * tstep;
    S.a_ready(cur);
    if constexpr (SP2) {
        PG8_STAGE(PG8_SB(0, 0), cB, voffB); PG8_STAGE(PG8_SB(0, 1), cB + hstep, voffB); PG8_STAGE(PG8_SA(0, 0), cA, voffA); PG8_STAGE(PG8_SA(0, 1), cA + hstep, voffA);
        if (wr == 1) PG8_BAR;
        PG8_WAIT_V(2); PG8_BAR;
        PG8_STAGE(PG8_SB(1, 0), cB + kstep, voffB); PG8_STAGE(PG8_SA(1, 0), cA + kstep, voffA); PG8_STAGE(PG8_SB(1, 1), cB + hstep + kstep, voffB);
        PG8_WAIT_V(6); PG8_BAR;
    } else {
        PG8_STAGE(PG8_SB(0, 0), cB, voffB); PG8_STAGE(PG8_SA(0, 0), cA, voffA); PG8_STAGE(PG8_SB(0, 1), cB + hstep, voffB); PG8_STAGE(PG8_SA(0, 1), cA + hstep, voffA);
        if (wr == 1) PG8_BAR;
        PG8_WAIT_V(4); PG8_BAR;
        PG8_STAGE(PG8_SB(1, 0), cB + kstep, voffB); PG8_STAGE(PG8_SA(1, 0), cA + kstep, voffA); PG8_STAGE(PG8_SB(1, 1), cB + hstep + kstep, voffB);
        PG8_WAIT_V(6); PG8_BAR;
    }
    for (;;) {
        const bool has_next = S.next(ui + 1, nxt);
        const char* nA = has_next ? (const char*)g.A + (size_t)nxt.pm * tstep : cA; const char* nB = has_next ? (const char*)g.Bt + (size_t)nxt.pn * tstep : cB;
        for (int t = 0; t < nt; t += 2) {
            const bool last = (t == nt - 2);
            const char* a1 = cA + (size_t)(t + 1) * kstep;
            const char* a2 = last ? nA : cA + (size_t)(t + 2) * kstep; const char* b2 = last ? nB : cB + (size_t)(t + 2) * kstep;
            const char* a3 = a2 + kstep; const char* b3 = b2 + kstep;
            if (last && has_next) S.a_ready(nxt);
            if constexpr (SP2) {
            PG8_LDB(B0, 0, 0); PG8_LDB(B1, 0, 1); PG8_SCHED; PG8_LDA(At, 0, 0); PG8_STAGE(PG8_SA(1, 1), a1 + hstep, voffA);
            PG8_WAIT_V(8); PG8_WAIT_L(0); PG8_BAR; PG8_MMA(0, 0, At, B0); PG8_MMA(0, 1, At, B1); PG8_BAR; PG8_SCHED;
            PG8_LDA(At, 0, 1); PG8_STAGE(PG8_SB(0, 0), b2, voffB); PG8_STAGE(PG8_SB(0, 1), b2 + hstep, voffB); PG8_STAGE(PG8_SA(0, 0), a2, voffA);
            PG8_WAIT_V(8); PG8_WAIT_L(0); PG8_BAR; PG8_MMA(1, 0, At, B0); PG8_MMA(1, 1, At, B1); PG8_BAR; PG8_SCHED;
            PG8_LDB(B0, 1, 0); PG8_LDB(B1, 1, 1); PG8_SCHED; PG8_LDA(At, 1, 0); PG8_STAGE(PG8_SA(0, 1), a2 + hstep, voffA);
            PG8_WAIT_V(8); PG8_WAIT_L(0); PG8_BAR; PG8_MMA(0, 0, At, B0); PG8_MMA(0, 1, At, B1); PG8_BAR; PG8_SCHED;
            PG8_LDA(At, 1, 1); PG8_STAGE(PG8_SB(1, 0), b3, voffB); PG8_STAGE(PG8_SB(1, 1), b3 + hstep, voffB); PG8_STAGE(PG8_SA(1, 0), a3, voffA);
            PG8_WAIT_V(8); PG8_WAIT_L(0); PG8_BAR; PG8_MMA(1, 0, At, B0); PG8_MMA(1, 1, At, B1); PG8_BAR; PG8_SCHED;
            } else {
            PG8_LDB(B0, 0, 0); PG8_SCHED; PG8_LDA(At, 0, 0); PG8_STAGE(PG8_SA(1, 1), a1 + hstep, voffA);
            PG8_WAIT_L(8); PG8_BAR; PG8_WAIT_L(0); PG8_MMA(0, 0, At, B0); PG8_BAR; PG8_SCHED;
            PG8_LDB(B1, 0, 1); PG8_STAGE(PG8_SB(0, 0), b2, voffB);
            PG8_BAR; PG8_WAIT_L(0); PG8_MMA(0, 1, At, B1); PG8_BAR;
            PG8_LDA(At, 0, 1); PG8_STAGE(PG8_SA(0, 0), a2, voffA);
            PG8_BAR; PG8_WAIT_L(0); PG8_MMA(1, 0, At, B0); PG8_BAR; PG8_SCHED;
            PG8_STAGE(PG8_SB(0, 1), b2 + hstep, voffB);
            PG8_WAIT_V(6); PG8_BAR; PG8_MMA(1, 1, At, B1); PG8_BAR;
            PG8_LDB(B0, 1, 0); PG8_SCHED; PG8_LDA(At, 1, 0); PG8_STAGE(PG8_SA(0, 1), a2 + hstep, voffA);
            PG8_WAIT_L(8); PG8_BAR; PG8_WAIT_L(0); PG8_MMA(0, 0, At, B0); PG8_BAR; PG8_SCHED;
            PG8_LDB(B1, 1, 1); PG8_STAGE(PG8_SB(1, 0), b3, voffB);
            PG8_BAR; PG8_WAIT_L(0); PG8_MMA(0, 1, At, B1); PG8_BAR;
            PG8_LDA(At, 1, 1); PG8_STAGE(PG8_SA(1, 0), a3, voffA);
            PG8_BAR; PG8_WAIT_L(0); PG8_MMA(1, 0, At, B0); PG8_BAR; PG8_SCHED;
            PG8_STAGE(PG8_SB(1, 1), b3 + hstep, voffB);
            PG8_WAIT_V(6); PG8_BAR; PG8_MMA(1, 1, At, B1); PG8_BAR;
            }
        }
        if constexpr (ALIGN_EPI) { if (wr == 0) PG8_BAR; }
        if constexpr (!Epi::AFTER_DRAIN) { E(acc, cur, wr, wc, fr, fq); S.done(cur); }
        if (!has_next) break;
#pragma unroll
        for (int a = 0; a < 2; ++a)
#pragma unroll
            for (int b = 0; b < 2; ++b)
#pragma unroll
                for (int m = 0; m < 4; ++m)
#pragma unroll
                    for (int n = 0; n < 2; ++n) acc[a][b][m][n] = (f32x4){0.f, 0.f, 0.f, 0.f};
        cur = nxt; cA = nA; cB = nB; ++ui;
        if constexpr (ALIGN_EPI) { if (wr == 1) PG8_BAR; }
    }
    PG8_WAIT_V(0);
    if constexpr (!ALIGN_EPI) { if (wr == 0) PG8_BAR; }
    PG8_BAR;
    if constexpr (Epi::AFTER_DRAIN) { E.fused(acc, cur, wr, wc, fr, fq, lds, wid, lane); S.done(cur); }
#undef PG8_SA
#undef PG8_SB
#undef PG8_STAGE
#undef PG8_LDA
#undef PG8_LDB
#undef PG8_MMA
#undef PG8_WAIT_V
#undef PG8_WAIT_L
#undef PG8_BAR
#undef PG8_SCHED
}
}

#define LAS __attribute__((address_space(3)))
typedef unsigned short bf16;
typedef short bf16x8 __attribute__((ext_vector_type(8)));
typedef float f32x4 __attribute__((ext_vector_type(4)));
typedef float f32x16 __attribute__((ext_vector_type(16)));
typedef unsigned u32x4 __attribute__((ext_vector_type(4)));
typedef unsigned u32x2 __attribute__((ext_vector_type(2)));
constexpr int NB = 2, SEQ = 16384, T = NB * SEQ, D = 1024, FF = 2816, NH = 8;
constexpr float LOG2E = 1.4426950408889634f;
constexpr float LAMBDA_INIT = 0.35550906759f;
constexpr float QSCALE = 0.125f * LOG2E;
constexpr size_t MiB = 1u << 20;
constexpr size_t WS_SMALL = 0;
constexpr size_t WS_XBAR = 1600000;
constexpr size_t WS_WGU = 2 * MiB, WGU_BYTES = (size_t)2 * FF * D * 2;
constexpr size_t WS_WDN = 46 * MiB, WDN_BYTES = (size_t)D * FF * 2;
constexpr size_t WS_WIN = 68 * MiB, WS_WOUT = 72 * MiB, WS_WK = 74 * MiB, WS_WV = 76 * MiB, WS_WQ = 78 * MiB, WS_WO = 80 * MiB;
constexpr size_t WS_XB = 82 * MiB;
constexpr size_t WS_ACT = 146 * MiB;
constexpr size_t WS_KB = 322 * MiB;
constexpr size_t WS_VT = 386 * MiB;
constexpr size_t WS_END = 450 * MiB;
static_assert(WS_WGU + 4 * WGU_BYTES <= WS_WDN && WS_WDN + 4 * WDN_BYTES <= WS_WIN && WS_ACT + (size_t)T * FF * 2 <= WS_KB, "ws map");
constexpr int LDS_BYTES = 135168;
constexpr int LDS_CTL = 131072;

__device__ __forceinline__ unsigned pk2(float lo, float hi) { return pg8::cvt_pk_bf16(lo, hi); }
__device__ __forceinline__ unsigned f2bf(float f) { return pg8::cvt_pk_bf16(f, f) & 0xffffu; }
__device__ __forceinline__ float bf2f(unsigned short b) { return __builtin_bit_cast(float, (unsigned)b << 16); }
__device__ __forceinline__ float wave_sum(float v) {
#pragma unroll
    for (int o = 1; o < 64; o <<= 1) v += __shfl_xor(v, o);
    return v;
}
__device__ __forceinline__ float swap_max(float v) { auto rr = __builtin_amdgcn_permlane32_swap(__float_as_uint(v), __float_as_uint(v), false, false); return fmaxf(__uint_as_float(rr[0]), __uint_as_float(rr[1])); }
__device__ __forceinline__ float swap_sum(float v) { auto rr = __builtin_amdgcn_permlane32_swap(__float_as_uint(v), __float_as_uint(v), false, false); return __uint_as_float(rr[0]) + __uint_as_float(rr[1]); }

struct Params { const float* in[27]; float* out; unsigned char* ws; };

#define XB_TMO      128
#define XB_XCNT(j)  (256  + 64 * (j))
#define XB_XSUB(j)  (1280 + 64 * (j))
#define XB_XGEN(j)  (2304 + 64 * (j))
#define XB_TOP      3328
#define XB_TOPGEN   3392
#define XCD_BAR_WORDS 3456
#define XB_SPIN_CAP (1u << 18)

__device__ __forceinline__ unsigned xb_ld(unsigned* p)              { return __hip_atomic_load(p, __ATOMIC_RELAXED, __HIP_MEMORY_SCOPE_AGENT); }
__device__ __forceinline__ unsigned xb_add(unsigned* p, unsigned v) { return __hip_atomic_fetch_add(p, v, __ATOMIC_RELAXED, __HIP_MEMORY_SCOPE_AGENT); }
__device__ __forceinline__ unsigned xb_xcc_id() { return (unsigned)__builtin_amdgcn_s_getreg((3 << 11) | 20) & 0xFu; }
#define XB_SPIN(cond, bar) do { unsigned _sp = 0; while (cond) { __builtin_amdgcn_s_sleep(1); \
    if ((++_sp & 255u) == 0u) { if (xb_ld(&(bar)[XB_TMO])) break; if (_sp > XB_SPIN_CAP) { atomicAdd(&(bar)[XB_TMO], 1u); break; } } } } while (0)

struct XcdBarrier {
    unsigned* bar; unsigned x;
    volatile LAS unsigned* st;
};

__device__ __forceinline__ XcdBarrier xcd_barrier_post(unsigned* bar, volatile LAS unsigned* st) {
    XcdBarrier b; b.bar = bar; b.x = xb_xcc_id(); b.st = st;
    if (threadIdx.x == 0) (void)xb_add(&bar[XB_XCNT(b.x)], 1u);
    return b;
}
__device__ __forceinline__ void xcd_barrier_complete(unsigned* bar, unsigned x, unsigned& nloc, unsigned& nx) {
    const unsigned G = gridDim.x * gridDim.y * gridDim.z;
    unsigned sum, cnt, mine, sp = 0u;
    for (;;) {
        sum = 0u; cnt = 0u; mine = 0u;
#pragma unroll
        for (unsigned j = 0; j < 16; ++j) { const unsigned c = xb_ld(&bar[XB_XCNT(j)]); sum += c; cnt += (c > 0u) ? 1u : 0u; mine = (j == x) ? c : mine; }
        if (sum == G) break;
        __builtin_amdgcn_s_sleep(1);
        if ((++sp & 255u) == 0u) { if (xb_ld(&bar[XB_TMO])) break; if (sp > XB_SPIN_CAP) { atomicAdd(&bar[XB_TMO], 1u); break; } }
    }
    nloc = mine > 0u ? mine : 1u; nx = cnt > 0u ? cnt : 1u;
}

__device__ __forceinline__ void xcd_barrier(const XcdBarrier& b) {
    asm volatile("s_waitcnt vmcnt(0)" ::: "memory");
    __syncthreads();
    if (threadIdx.x == 0) {
        unsigned* bar = b.bar;
        __builtin_amdgcn_s_waitcnt(0);
        unsigned nloc = b.st[0], nx = b.st[1];
        if (nloc == 0u) { xcd_barrier_complete(bar, b.x, nloc, nx); b.st[0] = nloc; b.st[1] = nx; }
        const unsigned old = xb_add(&bar[XB_XSUB(b.x)], 1u);
        const unsigned gen = old / nloc;
        if (old + 1u == (gen + 1u) * nloc) {
            __builtin_amdgcn_fence(__ATOMIC_RELEASE, "agent");
            asm volatile("s_waitcnt vmcnt(0)" ::: "memory");
            const unsigned og = xb_add(&bar[XB_TOP], 1u);
            const unsigned tg = og / nx;
            if (og + 1u == (tg + 1u) * nx) xb_add(&bar[XB_TOPGEN], 1u);
            else XB_SPIN(xb_ld(&bar[XB_TOPGEN]) == tg, bar);
            __builtin_amdgcn_fence(__ATOMIC_ACQUIRE, "agent");
            xb_add(&bar[XB_XGEN(b.x)], 1u);
            asm volatile("s_waitcnt vmcnt(0)" ::: "memory");
        } else {
            XB_SPIN(xb_ld(&bar[XB_XGEN(b.x)]) == gen, bar);
            __builtin_amdgcn_fence(__ATOMIC_ACQUIRE, "agent");
            asm volatile("s_waitcnt vmcnt(0)" ::: "memory");
        }
    }
    __syncthreads();
}
__device__ __forceinline__ void transpose_item(const float* W, int K, int N, bf16* WT, int mode, const float* gk, int gmask, float gmul, LAS float* scr, int item, int lane) {
    const int nblk = N / 32, kb = item / nblk, nb = item % nblk, k0 = 64 * kb, n0 = 32 * nb;
    const int n4 = (lane & 7) * 4, kr = lane >> 3;
    f32x4 v[8];
#pragma unroll
    for (int i = 0; i < 8; ++i) v[i] = __builtin_nontemporal_load((const f32x4*)(W + (size_t)(k0 + 8 * i + kr) * N + n0 + n4));
    if (gk) {
#pragma unroll
        for (int i = 0; i < 8; ++i) v[i] = v[i] * (gk[(k0 + 8 * i + kr) & gmask] * gmul);
    }
#pragma unroll
    for (int i = 0; i < 8; ++i) { LAS float* d = scr + (8 * i + kr) * 33 + n4; d[0] = v[i][0]; d[1] = v[i][1]; d[2] = v[i][2]; d[3] = v[i][3]; }
    asm volatile("s_waitcnt lgkmcnt(0)" ::: "memory");
    const int c = lane & 7;
    int nbase = n0; if (mode != 0) nbase = (n0 >> 7) * 256 + (n0 & 127) + (mode == 2 ? 128 : 0);
#pragma unroll
    for (int j = 0; j < 4; ++j) { const int n = (lane >> 3) + 8 * j; const LAS float* s = scr + (8 * c) * 33 + n;
        u32x4 o; o.x = pk2(s[0 * 33], s[1 * 33]); o.y = pk2(s[2 * 33], s[3 * 33]); o.z = pk2(s[4 * 33], s[5 * 33]); o.w = pk2(s[6 * 33], s[7 * 33]);
        *(u32x4*)(WT + (size_t)(nbase + n) * K + k0 + 8 * c) = o; }
    asm volatile("s_waitcnt lgkmcnt(0)" ::: "memory");
}
__device__ __forceinline__ void prologue(const Params& p, LAS unsigned char* lds, int G, int bid, int tid) {
    asm volatile("" : "+v"(tid)); asm volatile("" : "+s"(G), "+s"(bid));
    const int lane = tid & 63, wave = tid >> 6;
    LAS float* scr = (LAS float*)(lds + wave * 16384);
    const int gw = bid * 8 + wave, NGW = G * 8;
    unsigned char* ws = p.ws;
    float* small = (float*)(ws + WS_SMALL);
#pragma unroll 1
    for (int i = bid * 512 + tid; i < 8 * T + 64; i += G * 512) small[T + i] = 0.f;
    const float* x = p.in[0]; bf16* xb = (bf16*)(ws + WS_XB);
#pragma unroll 1
    for (int m = gw; m < T; m += 2 * NGW) {
        const int m2 = m + NGW;
        const bool has2 = m2 < T;
        const f32x4* xr = (const f32x4*)(x + (size_t)m * D) + lane; const f32x4* xr2 = (const f32x4*)(x + (size_t)(has2 ? m2 : m) * D) + lane;
        f32x4 v[4], v2[4]; float s = 0.f, s2 = 0.f;
#pragma unroll
        for (int j = 0; j < 4; ++j) { v[j] = __builtin_nontemporal_load(xr + 64 * j); v2[j] = __builtin_nontemporal_load(xr2 + 64 * j); }
#pragma unroll
        for (int j = 0; j < 4; ++j) { s += (v[j][0] * v[j][0] + v[j][1] * v[j][1]) + (v[j][2] * v[j][2] + v[j][3] * v[j][3]); s2 += (v2[j][0] * v2[j][0] + v2[j][1] * v2[j][1]) + (v2[j][2] * v2[j][2] + v2[j][3] * v2[j][3]); }
        s = wave_sum(s); s2 = wave_sum(s2);
        u32x2* brow = (u32x2*)(xb + (size_t)m * D) + lane; u32x2* brow2 = (u32x2*)(xb + (size_t)m2 * D) + lane;
#pragma unroll
        for (int j = 0; j < 4; ++j) { u32x2 w; w.x = pk2(v[j][0], v[j][1]); w.y = pk2(v[j][2], v[j][3]); brow[64 * j] = w;
            if (has2) { u32x2 w2; w2.x = pk2(v2[j][0], v2[j][1]); w2.y = pk2(v2[j][2], v2[j][3]); brow2[64 * j] = w2; } }
        if (lane == 0) { small[m] = s; if (has2) small[m2] = s2; }
    }
    constexpr int I_F = 1408, N_FFN = 12 * I_F, I_IN = 1024, I_SQ = 512;
    constexpr int NITEMS = N_FFN + I_IN + 5 * I_SQ;
#pragma unroll 1
    for (int it = gw; it < NITEMS; it += NGW) {
        if (it < N_FFN) {
            const int mid = it / I_F, r = it % I_F, f = mid / 3, kind = mid % 3, l = f >> 1, second = f & 1;
            const float* g = p.in[second ? 6 : 1] + l * D;
            if (kind == 0)      transpose_item(p.in[second ? 7 : 2] + (size_t)l * D * FF, D, FF, (bf16*)(ws + WS_WGU + f * WGU_BYTES), 1, g, 1023, 1.f, scr, r, lane);
            else if (kind == 1) transpose_item(p.in[second ? 8 : 3] + (size_t)l * D * FF, D, FF, (bf16*)(ws + WS_WGU + f * WGU_BYTES), 2, g, 1023, 1.f, scr, r, lane);
            else                transpose_item(p.in[second ? 9 : 4] + (size_t)l * D * FF, FF, D, (bf16*)(ws + WS_WDN + f * WDN_BYTES), 0, nullptr, 0, 1.f, scr, r, lane);
        } else {
            int r = it - N_FFN;
            if (r < I_IN) { transpose_item(p.in[10], D, 2 * D, (bf16*)(ws + WS_WIN), 0, p.in[5], 1023, 1.f, scr, r, lane); continue; }
            r -= I_IN; const int mid = r / I_SQ; r = r % I_SQ;
            if (mid == 0)      transpose_item(p.in[15], D, D, (bf16*)(ws + WS_WOUT), 0, nullptr, 0, 1.f, scr, r, lane);
            else if (mid == 1) transpose_item(p.in[17], D, D, (bf16*)(ws + WS_WK), 0, p.in[16], 1023, 1.f, scr, r, lane);
            else if (mid == 2) transpose_item(p.in[18], D, D, (bf16*)(ws + WS_WV), 0, p.in[16], 1023, 1.f, scr, r, lane);
            else if (mid == 3) transpose_item(p.in[19], D, D, (bf16*)(ws + WS_WQ), 0, p.in[5] + D, 1023, 1.f, scr, r, lane);
            else               transpose_item(p.in[25], D, D, (bf16*)(ws + WS_WO), 0, p.in[24], 127, 1.0f - LAMBDA_INIT, scr, r, lane);
        }
    }
}

__device__ __forceinline__ void spatial_phase(const Params& p, LAS unsigned char* lds, int G, int bid, int tid) {
    asm volatile("" : "+v"(tid)); asm volatile("" : "+s"(G), "+s"(bid));
    const int lane = tid & 63, w = tid >> 6, r32 = lane & 31, hi = lane >> 5;
    unsigned char* ws = p.ws;
    const bf16* Z = (const bf16*)(ws + WS_ACT); bf16* Gt = (bf16*)(ws + WS_KB);
    const float* small = (const float*)(ws + WS_SMALL); const float* vsum = small + 7 * T; const float* vsq = small + 8 * T;
    const float* wsp = p.in[13]; const float* bsp = p.in[14]; const float* lng = p.in[11]; const float* lnb = p.in[12];
    LAS unsigned char* As = lds; LAS unsigned char* Bs = lds + 34816;
    const int s = tid & 127, cq = tid >> 7;
    const int tr = 32 * (w & 3), cc = 64 * (w >> 2), nks = 2 * (w & 3) + 2;
    int cur_g = -1;
    u32x4 braw[4]; float bsum = 0.f, bsq = 0.f;
#define SP_LOADB(unit_) do { const int n_ = (unit_) >> 3, g_ = (unit_) & 7; const bf16* zr_ = Z + (size_t)(n_ * 128 + s) * 2048 + 1024 + g_ * 128 + cq * 8; \
        _Pragma("unroll") for (int j = 0; j < 4; ++j) braw[j] = *(const u32x4*)(zr_ + 32 * j); bsum = vsum[n_ * 128 + s]; bsq = vsq[n_ * 128 + s]; } while (0)
    if (bid < 2048) SP_LOADB(bid);
    for (int unit = bid; unit < 2048; unit += G) {
        const int n = unit >> 3, g = unit & 7, t0 = n * 128;
        if (g != cur_g) {
            cur_g = g;
#pragma unroll
            for (int j = 0; j < 8; ++j) { const int c = tid + 512 * j, t = c >> 5, s4 = (c & 31) * 4;
                f32x4 v = *(const f32x4*)(wsp + (size_t)g * 16384 + t * 128 + s4);
#pragma unroll
                for (int e = 0; e < 4; ++e) if (s4 + e > t) v[e] = 0.f;
                u32x2 o; o.x = pk2(v[0], v[1]); o.y = pk2(v[2], v[3]);
                *(LAS u32x2*)(As + t * 272 + s4 * 2) = o; }
        }
        { const float mu = bsum * (1.0f / 1024.0f); const float var = bsq * (1.0f / 1024.0f) - mu * mu; const float rstd = 1.0f / sqrtf(fmaxf(var, 0.f) + 1e-5f);
#pragma unroll
          for (int j = 0; j < 4; ++j) { const int c8 = (cq + 4 * j) * 8;
            const f32x4 g0 = *(const f32x4*)(lng + g * 128 + c8), g1 = *(const f32x4*)(lng + g * 128 + c8 + 4), b0 = *(const f32x4*)(lnb + g * 128 + c8), b1 = *(const f32x4*)(lnb + g * 128 + c8 + 4);
#pragma unroll
            for (int e = 0; e < 8; ++e) { const unsigned wd = braw[j][e >> 1]; const float val = bf2f((unsigned short)((e & 1) ? (wd >> 16) : (wd & 0xffffu)));
                const float gg = e < 4 ? g0[e & 3] : g1[e & 3], bb = e < 4 ? b0[e & 3] : b1[e & 3];
                *(LAS unsigned short*)(Bs + (c8 + e) * 272 + s * 2) = (unsigned short)f2bf((val - mu) * rstd * gg + bb); } } }
        __syncthreads();
        if (unit + G < 2048) SP_LOADB(unit + G);
        const int t = tr + r32;
        const bf16* up = Z + (size_t)(t0 + t) * 2048 + g * 128 + cc + 4 * hi;
        u32x2 uu[2][4];
#pragma unroll
        for (int blk = 0; blk < 2; ++blk)
#pragma unroll
            for (int g4 = 0; g4 < 4; ++g4) uu[blk][g4] = *(const u32x2*)(up + 32 * blk + 8 * g4);
        const float bias = bsp[g * 128 + t];
        f32x16 d0 = {}, d1 = {};
        for (int ks = 0; ks < nks; ++ks) {
            const bf16x8 a = *(const LAS bf16x8*)(As + (tr + r32) * 272 + (16 * ks + 8 * hi) * 2);
            const bf16x8 b0 = *(const LAS bf16x8*)(Bs + (cc + r32) * 272 + (16 * ks + 8 * hi) * 2);
            const bf16x8 b1 = *(const LAS bf16x8*)(Bs + (cc + 32 + r32) * 272 + (16 * ks + 8 * hi) * 2);
            d0 = __builtin_amdgcn_mfma_f32_32x32x16_bf16(b0, a, d0, 0, 0, 0);
            d1 = __builtin_amdgcn_mfma_f32_32x32x16_bf16(b1, a, d1, 0, 0, 0);
        }
        bf16* gp = Gt + (size_t)(t0 + t) * 1024 + g * 128 + cc + 4 * hi;
#pragma unroll
        for (int g4 = 0; g4 < 4; ++g4) {
            { const unsigned u0 = uu[0][g4].x, u1 = uu[0][g4].y; u32x2 o;
              o.x = pk2(__uint_as_float(u0 << 16) * (d0[4 * g4] + bias), __uint_as_float(u0 & 0xffff0000u) * (d0[4 * g4 + 1] + bias));
              o.y = pk2(__uint_as_float(u1 << 16) * (d0[4 * g4 + 2] + bias), __uint_as_float(u1 & 0xffff0000u) * (d0[4 * g4 + 3] + bias));
              *(u32x2*)(gp + 8 * g4) = o; }
            { const unsigned u0 = uu[1][g4].x, u1 = uu[1][g4].y; u32x2 o;
              o.x = pk2(__uint_as_float(u0 << 16) * (d1[4 * g4] + bias), __uint_as_float(u0 & 0xffff0000u) * (d1[4 * g4 + 1] + bias));
              o.y = pk2(__uint_as_float(u1 << 16) * (d1[4 * g4 + 2] + bias), __uint_as_float(u1 & 0xffff0000u) * (d1[4 * g4 + 3] + bias));
              *(u32x2*)(gp + 32 + 8 * g4) = o; }
        }
        __syncthreads();
    }
#undef SP_LOADB
}

__device__ __forceinline__ void knorm_pass(const Params& p, int G, int bid, int tid) {
    asm volatile("" : "+v"(tid)); asm volatile("" : "+s"(G), "+s"(bid));
    const int lane = tid & 63, wave = tid >> 6; const int gw = bid * 8 + wave, NGW = G * 8;
    const bf16* Kb = (const bf16*)(p.ws + WS_KB); unsigned* knmax = (unsigned*)(p.ws + WS_SMALL) + 9 * T + 16;
    float mx0 = 0.f, mx1 = 0.f;
    for (int m = gw; m < T; m += NGW) {
        const u32x4* kr = (const u32x4*)(Kb + (size_t)m * 1024) + 2 * lane;
        const u32x4 a = kr[0], c = kr[1]; float s = 0.f;
#pragma unroll
        for (int e = 0; e < 4; ++e) { const float a0 = __uint_as_float(a[e] << 16), a1 = __uint_as_float(a[e] & 0xffff0000u), c0 = __uint_as_float(c[e] << 16), c1 = __uint_as_float(c[e] & 0xffff0000u);
            s += (a0 * a0 + a1 * a1) + (c0 * c0 + c1 * c1); }
        s += __shfl_xor(s, 1); s += __shfl_xor(s, 2);
        if (m < SEQ) mx0 = fmaxf(mx0, s); else mx1 = fmaxf(mx1, s);
    }
    if ((lane & 3) == 0) { atomicMax(knmax + (lane >> 2), __float_as_uint(mx0)); atomicMax(knmax + 16 + (lane >> 2), __float_as_uint(mx1)); }
}

constexpr int AT_KS = 64 * 272, AT_VS = 128 * 144, AT_STAGE = AT_KS + AT_VS;
constexpr float AT_THR = 8.0f;
template <int MODE>
__device__ __forceinline__ void attn_phase(const Params& p, LAS unsigned char* lds, int tid, int cidx, bf16* O) {
    asm volatile("" : "+v"(tid));
    const int lane = tid & 63, w = __builtin_amdgcn_readfirstlane(tid >> 6), r32 = lane & 31, hi = lane >> 5;
    const int br = w >> 2, rq = 32 * (w & 3);
    unsigned char* ws = p.ws;
    const bf16* Q = (const bf16*)(ws + WS_ACT); const bf16* Kb = (const bf16*)(ws + WS_KB); const bf16* VT = (const bf16*)(ws + WS_VT);
    unsigned* counter = (unsigned*)(ws + WS_SMALL) + 9 * T + cidx; const float* knmax = (const float*)(ws + WS_SMALL) + 9 * T + 16;
    float lam;
    { float a = p.in[20][lane] * p.in[21][lane], b = p.in[22][lane] * p.in[23][lane]; a = wave_sum(a); b = wave_sum(b); lam = __expf(a) - __expf(b) + LAMBDA_INIT; }
    volatile LAS unsigned* nxt = (volatile LAS unsigned*)(lds + LDS_CTL);
    volatile LAS float* qnw = (volatile LAS float*)(lds + LDS_CTL + 64);
    const int sig = (r32 & ~12) | ((r32 & 4) << 1) | ((r32 & 8) >> 1);
    for (;;) {
        if (tid == 0) *nxt = atomicAdd(counter, 1u);
        __syncthreads();
        const int u = (int)*nxt;
        if (u >= 2048) break;
        int qb, b, h;
        if (u < 512) { qb = 127 - (u >> 2); b = (u >> 1) & 1; h = 7 - (u & 1); }
        else { const int v = u - 512; h = 5 - (v >> 8); qb = 127 - ((v & 255) >> 1); b = v & 1; }
        const int q0 = qb * 128, NT = (q0 + 128) / 64;
        const float slope2 = __builtin_amdgcn_exp2f(-(float)(h + 1)) * LOG2E;
        float so16 = slope2 * 16.0f, so32 = slope2 * 32.0f, so48 = slope2 * 48.0f; asm volatile("" : "+v"(so16), "+v"(so32), "+v"(so48));
        const size_t rowbase = (size_t)b * SEQ;
        bf16x8 qf[4];
        { const bf16* qp = Q + (rowbase + q0 + rq + r32) * 1024 + h * 128 + br * 64 + hi * 8;
#pragma unroll
          for (int d = 0; d < 4; ++d) qf[d] = *(const bf16x8*)(qp + 16 * d); }
        { float s = 0.f;
#pragma unroll
          for (int d = 0; d < 4; ++d)
#pragma unroll
              for (int e = 0; e < 8; ++e) { const float v = __uint_as_float((unsigned)(unsigned short)qf[d][e] << 16); s += v * v; }
          s = swap_sum(s);
#pragma unroll
          for (int o = 1; o < 32; o <<= 1) s = fmaxf(s, __shfl_xor(s, o));
          if (lane == 0) qnw[w] = s; }
        __syncthreads();
        int t0;
        { const float q1 = fmaxf(fmaxf(qnw[0], qnw[1]), fmaxf(qnw[2], qnw[3])), q2 = fmaxf(fmaxf(qnw[4], qnw[5]), fmaxf(qnw[6], qnw[7]));
          const float k1 = knmax[b * 16 + h * 2], k2 = knmax[b * 16 + h * 2 + 1];
          const float bound = 2.0f * sqrtf(fmaxf(q1 * k1, q2 * k2)) * 1.002f + 0.25f;
          const float W = (150.0f + bound) / slope2;
          const float ts = floorf(((float)q0 - W - 63.0f) * (1.0f / 64.0f));
          t0 = ts > 0.f ? (int)ts : 0; if (t0 > NT - 1) t0 = NT - 1;
          t0 = __builtin_amdgcn_readfirstlane(t0); }
        const bf16* kg[2]; const bf16* vg[2]; int kl[2], vl[2];
#pragma unroll
        for (int j = 0; j < 2; ++j) { const int c = tid + 512 * j; const int krow = c >> 4, kcc = c & 15, vrow = c >> 3, vcc = c & 7;
            kg[j] = Kb + (rowbase + krow) * 1024 + h * 128 + kcc * 8; kl[j] = krow * 272 + kcc * 16;
            vg[j] = VT + (size_t)(h * 128 + vrow) * T + rowbase + vcc * 8; vl[j] = AT_KS + vrow * 144 + vcc * 16; }
        u32x4 st[4];
#define AT_LOAD(t) do { _Pragma("unroll") for (int j = 0; j < 2; ++j) { st[j] = *(const u32x4*)(kg[j] + (size_t)(t) * 64 * 1024); st[2 + j] = *(const u32x4*)(vg[j] + (size_t)(t) * 64); } } while (0)
#define AT_STORE(buf) do { _Pragma("unroll") for (int j = 0; j < 2; ++j) { *(LAS u32x4*)(lds + (buf) * AT_STAGE + kl[j]) = st[j]; *(LAS u32x4*)(lds + (buf) * AT_STAGE + vl[j]) = st[2 + j]; } } while (0)
        AT_LOAD(t0); AT_STORE(t0 & 1);
        __syncthreads();
        f32x16 o[4];
#pragma unroll
        for (int d = 0; d < 4; ++d) o[d] = (f32x16){};
        float mu = 0.f, l = 0.f;
        bool first = true;
        const int qpos = q0 + rq + r32;
        for (int t = t0; t < NT; ++t) {
            const int buf = t & 1;
            if (t + 1 < NT) AT_LOAD(t + 1);
            if (64 * t <= q0 + rq + 31) {
                const LAS unsigned char* Kt = lds + buf * AT_STAGE; const LAS unsigned char* Vt = Kt + AT_KS;
                const LAS unsigned char* kp = Kt + sig * 272 + (br * 64 + 8 * hi) * 2; const LAS unsigned char* vp = Vt + r32 * 144 + 16 * hi;
                bf16x8 kf[2][4];
#pragma unroll
                for (int kb = 0; kb < 2; ++kb)
#pragma unroll
                    for (int d = 0; d < 4; ++d) kf[kb][d] = *(const LAS bf16x8*)(kp + kb * (32 * 272) + d * 32);
                const float fb = slope2 * (float)(64 * t - q0 + 8 * hi) - mu;
                f32x16 pr[2];
                { float b8[8];
#pragma unroll
                  for (int j = 0; j < 8; ++j) b8[j] = __builtin_fmaf(slope2, (float)j, fb);
#pragma unroll
                  for (int kb = 0; kb < 2; ++kb)
#pragma unroll
                      for (int r = 0; r < 16; ++r) { const int n16 = 2 * kb + (r >> 3); pr[kb][r] = n16 == 0 ? b8[r & 7] : b8[r & 7] + (n16 == 1 ? so16 : n16 == 2 ? so32 : so48); } }
                __builtin_amdgcn_s_waitcnt(0xC07F);     __builtin_amdgcn_sched_barrier(0);
                if (!(MODE & 4)) {
#pragma unroll
                for (int d = 0; d < 4; ++d)
#pragma unroll
                    for (int kb = 0; kb < 2; ++kb) pr[kb] = __builtin_amdgcn_mfma_f32_32x32x16_bf16(kf[kb][d], qf[d], pr[kb], 0, 0, 0);
                }
                bf16x8 vf[2][4];
#pragma unroll
                for (int ks = 0; ks < 2; ++ks)
#pragma unroll
                    for (int d = 0; d < 4; ++d) vf[ks][d] = *(const LAS bf16x8*)(vp + d * (32 * 144) + ks * 32);
                __builtin_amdgcn_sched_barrier(0);
                if (!(MODE & 1)) {
                if (64 * t + 63 > q0 + rq) {
                    const int kbase = 64 * t + 8 * hi;
#pragma unroll
                    for (int kb = 0; kb < 2; ++kb)
#pragma unroll
                        for (int r = 0; r < 16; ++r) if (kbase + 32 * kb + 16 * (r >> 3) + (r & 7) > qpos) pr[kb][r] = -INFINITY;
                }
                float mx;
                { float m8[8];
#pragma unroll
                  for (int j = 0; j < 4; ++j) { m8[j] = __builtin_fmaxf(__builtin_fmaxf(pr[0][4 * j], pr[0][4 * j + 1]), pr[0][4 * j + 2]); m8[4 + j] = __builtin_fmaxf(__builtin_fmaxf(pr[1][4 * j], pr[1][4 * j + 1]), pr[1][4 * j + 2]); }
#pragma unroll
                  for (int j = 0; j < 4; ++j) { m8[j] = __builtin_fmaxf(__builtin_fmaxf(m8[j], pr[0][4 * j + 3]), pr[1][4 * j + 3]); }
                  const float ma = __builtin_fmaxf(__builtin_fmaxf(m8[0], m8[1]), m8[2]), mb = __builtin_fmaxf(__builtin_fmaxf(m8[3], m8[4]), m8[5]);
                  mx = __builtin_fmaxf(__builtin_fmaxf(ma, mb), __builtin_fmaxf(m8[6], m8[7])); }
                mx = swap_max(mx);
                if (first || __any(mx > AT_THR)) {
                    const float dl = first ? mx : fmaxf(mx, 0.f); const float alpha = first ? 1.0f : __builtin_amdgcn_exp2f(-dl);
                    mu += dl; l *= alpha;
#pragma unroll
                    for (int kb = 0; kb < 2; ++kb)
#pragma unroll
                        for (int r = 0; r < 16; ++r) pr[kb][r] -= dl;
#pragma unroll
                    for (int d = 0; d < 4; ++d)
#pragma unroll
                        for (int r = 0; r < 16; ++r) o[d][r] *= alpha;
                    first = false;
                }
                }
                float rs4[4] = {0.f, 0.f, 0.f, 0.f};
                bf16x8 pw[4];
#pragma unroll
                for (int ks = 0; ks < 4; ++ks) { const int kb = ks >> 1, r0 = 8 * (ks & 1);
#pragma unroll
                    for (int r = r0; r < r0 + 8; ++r) { if (!(MODE & 1)) { const float e = __builtin_amdgcn_exp2f(pr[kb][r]); pr[kb][r] = e; rs4[r & 3] += e; } }
                    u32x4 t4; t4.x = pg8::cvt_pk_bf16(pr[kb][r0], pr[kb][r0 + 1]); t4.y = pg8::cvt_pk_bf16(pr[kb][r0 + 2], pr[kb][r0 + 3]); t4.z = pg8::cvt_pk_bf16(pr[kb][r0 + 4], pr[kb][r0 + 5]); t4.w = pg8::cvt_pk_bf16(pr[kb][r0 + 6], pr[kb][r0 + 7]);
                    pw[ks] = __builtin_bit_cast(bf16x8, t4); }
                l += (rs4[0] + rs4[1]) + (rs4[2] + rs4[3]);
                __builtin_amdgcn_s_waitcnt(0xC07F);     __builtin_amdgcn_sched_barrier(0);
#pragma unroll
                for (int ks = 0; ks < 2; ++ks)
#pragma unroll
                    for (int d = 0; d < 4; ++d) { if (!(MODE & 2)) o[d] = __builtin_amdgcn_mfma_f32_32x32x16_bf16(vf[ks][d], pw[ks], o[d], 0, 0, 0); }
#pragma unroll
                for (int ks = 0; ks < 2; ++ks)
#pragma unroll
                    for (int d = 0; d < 4; ++d) vf[ks][d] = *(const LAS bf16x8*)(vp + d * (32 * 144) + (ks + 2) * 32);
                __builtin_amdgcn_s_waitcnt(0xC07F);     __builtin_amdgcn_sched_barrier(0);
#pragma unroll
                for (int ks = 0; ks < 2; ++ks)
#pragma unroll
                    for (int d = 0; d < 4; ++d) { if (!(MODE & 2)) o[d] = __builtin_amdgcn_mfma_f32_32x32x16_bf16(vf[ks][d], pw[ks + 2], o[d], 0, 0, 0); }
            }
            if (t + 1 < NT) AT_STORE(buf ^ 1);
            __syncthreads();
        }
#undef AT_LOAD
#undef AT_STORE
        const float lt = swap_sum(l), inv = 1.0f / lt;
        LAS float* X = (LAS float*)lds;
        if (br == 1) { const float sc = inv * lam;
#pragma unroll
            for (int d = 0; d < 4; ++d)
#pragma unroll
                for (int r = 0; r < 16; ++r) X[((w & 3) * 64 + d * 16 + r) * 64 + lane] = o[d][r] * sc; }
        __syncthreads();
        if (br == 0) { float ss = 0.f;
#pragma unroll
            for (int d = 0; d < 4; ++d)
#pragma unroll
                for (int r = 0; r < 16; ++r) { const float v = o[d][r] * inv - X[((w & 3) * 64 + d * 16 + r) * 64 + lane]; o[d][r] = v; ss += v * v; }
            ss = swap_sum(ss);
            const float rn = __builtin_amdgcn_rsqf(ss * (1.0f / 128.0f) + 1e-6f);
            bf16* op = O + (rowbase + qpos) * 1024 + h * 128 + 4 * hi;
#pragma unroll
            for (int d = 0; d < 4; ++d)
#pragma unroll
                for (int g4 = 0; g4 < 4; ++g4) { u32x2 wv; wv.x = pg8::cvt_pk_bf16(o[d][4 * g4] * rn, o[d][4 * g4 + 1] * rn); wv.y = pg8::cvt_pk_bf16(o[d][4 * g4 + 2] * rn, o[d][4 * g4 + 3] * rn);
                    *(u32x2*)(op + 32 * d + 8 * g4) = wv; } }
        __syncthreads();
    }
}

__device__ __forceinline__ void final_phase(const Params& p, int G, int bid, int tid) {
    asm volatile("" : "+v"(tid)); asm volatile("" : "+s"(G), "+s"(bid));
    const int lane = tid & 63, wave = tid >> 6; const int gw = bid * 8 + wave, NGW = G * 8;
    const float* ssq = (const float*)(p.ws + WS_SMALL) + 6 * T; const f32x4* gp = (const f32x4*)p.in[26] + lane;
    const bf16* xh = (const bf16*)(p.ws + WS_XB);
    f32x4 gv[4];
#pragma unroll
    for (int j = 0; j < 4; ++j) gv[j] = gp[64 * j];
#pragma unroll 1
    for (int m = gw; m < T; m += NGW) { f32x4* orow = (f32x4*)(p.out + (size_t)m * D) + lane; const float rs = pg8::rstd_row(ssq, m);
        const u32x2* hrow = (const u32x2*)(xh + (size_t)m * D) + lane; const u32x2* lrow = (const u32x2*)((const bf16*)p.out + (size_t)m * 2048 + 1024) + lane;
        u32x2 hv[4], lv[4];
#pragma unroll
        for (int j = 0; j < 4; ++j) { hv[j] = hrow[64 * j]; lv[j] = lrow[64 * j]; }
        asm volatile("s_waitcnt vmcnt(0)" ::: "memory");
#pragma unroll
        for (int j = 0; j < 4; ++j) { f32x4 v;
            v[0] = __uint_as_float(hv[j].x << 16) + __uint_as_float(lv[j].x << 16); v[1] = __uint_as_float(hv[j].x & 0xffff0000u) + __uint_as_float(lv[j].x & 0xffff0000u);
            v[2] = __uint_as_float(hv[j].y << 16) + __uint_as_float(lv[j].y << 16); v[3] = __uint_as_float(hv[j].y & 0xffff0000u) + __uint_as_float(lv[j].y & 0xffff0000u);
            orow[64 * j] = v * rs * gv[j]; } }
}

__global__ void __launch_bounds__(512) yoco_fwd(Params p) {
    extern __shared__ __attribute__((aligned(16))) unsigned char lds_raw[];
    cg::grid_group grid = cg::this_grid();
    LAS unsigned char* lds = (LAS unsigned char*)lds_raw;
    const int tid = threadIdx.x, bid = blockIdx.x, G = gridDim.x;
    unsigned char* ws = p.ws;
    float* small = (float*)(ws + WS_SMALL);
    bf16* xb = (bf16*)(ws + WS_XB); bf16* act = (bf16*)(ws + WS_ACT); bf16* kbuf = (bf16*)(ws + WS_KB); bf16* vt = (bf16*)(ws + WS_VT);
    volatile LAS unsigned* xb_st = (volatile LAS unsigned*)(lds + LDS_CTL + 128);
    if (tid == 0) { xb_st[0] = 0u; xb_st[1] = 0u; }
    __syncthreads();
    XcdBarrier xbar = xcd_barrier_post((unsigned*)(ws + WS_XBAR), xb_st);
    if (p.ws == nullptr) grid.sync();
#pragma unroll 1
    for (int ph = 0; ph < 16; ++ph) {
        if (ph == 0) prologue(p, lds, G, bid, tid);
        if (ph == 10) knorm_pass(p, G, bid, tid);
        if (ph == 8 || ph == 10) {
            const bool isq = ph == 10;
            pg8::Gemm g{xb, (const bf16*)(ws + (isq ? WS_WQ : WS_WK)), T, D, D}; pg8::StaticOrder S; S.init(T, D, G, bid);
            pg8::EpiScale E{isq ? act : kbuf, small + (isq ? 4 : 3) * T, isq ? QSCALE : 1.0f};
            pg8::gemm_phase<pg8::EpiScale, pg8::StaticOrder, true, true>(lds, g, S, E);
        }
        if (ph == 8) {
            pg8::Gemm g{(const bf16*)(ws + WS_WV), xb, D, T, D}; pg8::StaticOrder S; S.init(D, T, G, bid);
            pg8::EpiScaleCol E{vt, small + 3 * T, T};
            pg8::gemm_phase<pg8::EpiScaleCol, pg8::StaticOrder, true, true>(lds, g, S, E);
        }
        if (ph == 1 || ph == 6 || ph == 8 || ph == 13) {
            const int f = ph == 1 ? 0 : ph == 6 ? 1 : ph == 8 ? 2 : 3, si = ph == 1 ? 0 : ph == 6 ? 2 : ph == 8 ? 3 : 5;
            pg8::Gemm g{xb, (const bf16*)(ws + WS_WGU + f * WGU_BYTES), T, 2 * FF, D}; pg8::StaticOrder S; S.init(T, 2 * FF, G, bid);
            pg8::EpiSwiGLU E{act, small + si * T};
            pg8::gemm_phase<pg8::EpiSwiGLU, pg8::StaticOrder, true, true>(lds, g, S, E);
        }
        if (ph == 2 || ph == 7 || ph == 9 || ph == 14 || ph == 5 || ph == 12) {
            const bf16* A; const bf16* B; int K; float coef; int so;
            if (ph == 5)       { A = kbuf; B = (const bf16*)(ws + WS_WOUT); K = D; coef = 1.f; so = 2; }
            else if (ph == 12) { A = (const bf16*)(ws + WS_ACT + 64 * MiB); B = (const bf16*)(ws + WS_WO); K = D; coef = 1.f; so = 5; }
            else { const int f = ph == 2 ? 0 : ph == 7 ? 1 : ph == 9 ? 2 : 3; A = act; B = (const bf16*)(ws + WS_WDN + f * WDN_BYTES); K = FF; coef = 0.5f; so = ph == 2 ? 1 : ph == 7 ? 3 : ph == 9 ? 4 : 6; }
            pg8::Gemm g{A, B, T, D, K}; pg8::StaticOrder S; S.init(T, D, G, bid);
            pg8::EpiResid E{ph == 2 ? p.in[0] : nullptr, xb, (bf16*)p.out + 1024, small + so * T, coef};
            pg8::gemm_phase<pg8::EpiResid, pg8::StaticOrder, true, true>(lds, g, S, E);
        }
        if (ph == 3) {
            pg8::Gemm g{xb, (const bf16*)(ws + WS_WIN), T, 2 * D, D}; pg8::StaticOrder S; S.init(T, 2 * D, G, bid);
            pg8::EpiGeluZ E{act, small + 1 * T, small + 7 * T, small + 8 * T};
            pg8::gemm_phase<pg8::EpiGeluZ, pg8::StaticOrder, true, true>(lds, g, S, E);
        }
        if (ph == 4) spatial_phase(p, lds, G, bid, tid);
        if (ph == 11) attn_phase<0>(p, lds, tid, 0, (bf16*)(ws + WS_ACT + 64 * MiB));
        if (ph == 15) final_phase(p, G, bid, tid);
        if (ph < 15) xcd_barrier(xbar);
    }
}

extern "C" void kernel_launch(void* const* d_in, const int* in_sizes, int n_in, void* d_out, int out_size, void* d_ws, size_t ws_size, hipStream_t stream) {
    static int grid = 0;
    if (grid == 0) {
        if (n_in != 27 || in_sizes[0] != T * D || out_size != T * D || ws_size < WS_END) { fprintf(stderr, "kernel_launch: unexpected shapes (n_in %d, in0 %d, out %d, ws %zu); nothing launched\n", n_in, n_in > 0 ? in_sizes[0] : -1, out_size, ws_size); grid = -1; return; }
        int dev = 0, cus = 0, per_cu = 0;
        hipGetDevice(&dev); hipDeviceGetAttribute(&cus, hipDeviceAttributeMultiprocessorCount, dev);
        hipFuncSetAttribute((const void*)yoco_fwd, hipFuncAttributeMaxDynamicSharedMemorySize, LDS_BYTES);
        hipOccupancyMaxActiveBlocksPerMultiprocessor(&per_cu, (const void*)yoco_fwd, 512, LDS_BYTES);
        (void)hipGetLastError();
        if (per_cu < 1) per_cu = 1;
        grid = cus * 1;
        if (grid <= 0) grid = 256;
    }
    if (grid < 0) return;
    (void)hipMemsetAsync((unsigned char*)d_ws + WS_XBAR, 0, XCD_BAR_WORDS * 4, stream);
    Params p{};
    for (int i = 0; i < 27; ++i) p.in[i] = (const float*)d_in[i];
    p.out = (float*)d_out; p.ws = (unsigned char*)d_ws;
    void* args[] = {&p};
    hipError_t e = hipLaunchCooperativeKernel((const void*)yoco_fwd, dim3(grid), dim3(512), args, LDS_BYTES, stream);
    if (e != hipSuccess) fprintf(stderr, "cooperative launch failed: %s (grid %d)\n", hipGetErrorString(e), grid);
}
```

```cpp
#include <hip/hip_runtime.h>
#include <hip/hip_cooperative_groups.h>
#include <cstdio>
#include <cstdint>
#include <cmath>
namespace cg = cooperative_groups;
namespace pg8 {
#define PG8_LAS __attribute__((address_space(3)))
typedef unsigned short bf16_t;
typedef short bf16x8 __attribute__((ext_vector_type(8)));
typedef float f32x4 __attribute__((ext_vector_type(4)));
typedef unsigned u32x4 __attribute__((ext_vector_type(4)));
constexpr int BM = 256, BK = 64, HALF = 128, HTB = HALF * BK * 2  , STAGE_BYTES = 8 * HTB, NXCD = 8, WGM = 8;

__host__ __device__ __forceinline__ int lds_byte(int r, int c) { const int st = (r >> 4) * 2 + (c >> 5), rr = r & 15, cc = c & 31, ob = rr * 64 + cc * 2; return st * 1024 + (ob ^ (((ob >> 9) & 1) << 5)); }
__host__ __device__ __forceinline__ void stage_rc(int b, int& R, int& C) { const int st = b / 1024, sb = b % 1024, swz = sb ^ (((sb >> 9) & 1) << 5); R = (st >> 1) * 16 + swz / 64; C = (st & 1) * 32 + (swz % 64) / 2; }
__host__ __device__ __forceinline__ int perm32(int rho) { const int n = rho >> 4, i = rho & 15; return 8 * (i >> 2) + 4 * n + (i & 3); }

struct Unit { int pm, pn; };
struct Gemm { const bf16_t* A; const bf16_t* Bt; int M, N, K; };

struct StaticOrder {
    int nM, nN, nwg, G, c;
    __host__ __device__ void init(int M, int N, int G_, int c_) { nM = M / BM; nN = N / BM; nwg = nM * nN; G = G_; c = c_; }
    __host__ __device__ bool next(int i, Unit& u) const {
        const long L = (long)i * G + c; if (L >= nwg) return false;
        int wgid = (int)L;
        if ((nwg & 7) == 0 && nM >= 4 && (nM & 3) == 0 && (nM >= 8 ? (nM & 7) == 0 : nM == 4)) {
            wgid = (wgid & 7) * (nwg >> 3) + (wgid >> 3);
            const unsigned nig = (unsigned)(WGM * nN), magic = (0xFFFFFFFFu / nig) + 1u;
            const unsigned gid = (unsigned)(((unsigned long long)(unsigned)wgid * magic) >> 32), rem = (unsigned)wgid - gid * nig;
            const int fm = (int)gid * WGM, gshift = nM >= 8 ? 3 : 2;
            u.pm = fm + (int)(rem & ((1u << gshift) - 1u)); u.pn = (int)(rem >> gshift); return true;
        }
        { const int q = nwg / NXCD, r = nwg % NXCD, xcd = wgid % NXCD, off = wgid / NXCD; wgid = (xcd < r ? xcd * (q + 1) : r * (q + 1) + (xcd - r) * q) + off; }
        const int nig = WGM * nN, gid = wgid / nig, fm = gid * WGM, gsz = (nM - fm) < WGM ? (nM - fm) : WGM;
        u.pm = fm + ((wgid % nig) % gsz); u.pn = (wgid % nig) / gsz; return true;
    }
    __device__ __forceinline__ void a_ready(const Unit&) const {}
    __device__ __forceinline__ void done(const Unit&) const {}
};

__device__ __forceinline__ unsigned cvt_pk_bf16(float lo, float hi) { unsigned r; asm volatile("v_cvt_pk_bf16_f32 %0, %1, %2" : "=v"(r) : "v"(lo), "v"(hi)); return r; }
typedef float f32x2 __attribute__((ext_vector_type(2)));
__device__ __forceinline__ f32x2 gelu_pk(f32x2 v) {
    const f32x2 av = __builtin_elementwise_abs(v), d = av * 0.2316418882f + 1.0f;
    f32x2 t; t.x = __builtin_amdgcn_rcpf(d.x); t.y = __builtin_amdgcn_rcpf(d.y);
    f32x2 q = t * 0.5307027145f + (-0.7265760135f); q = q * t + 0.7107068705f; q = q * t + (-0.142248368f); q = q * t + 0.127414796f; q = q * t;
    const f32x2 s = (v * v) * (-0.72134752044f);
    f32x2 e; e.x = __builtin_amdgcn_exp2f(s.x); e.y = __builtin_amdgcn_exp2f(s.y);
    const f32x2 m = v * (q * e), r = v - m;
    f32x2 o; o.x = v.x < 0.f ? m.x : r.x; o.y = v.y < 0.f ? m.y : r.y; return o;
}
__device__ __forceinline__ float rstd_row(const float* ssq, int row) { return __builtin_amdgcn_rsqf(ssq[row] * (1.0f / 1024.0f) + 1e-6f); }

__device__ __forceinline__ void rstd8(const float* ssq, int row0, float cs, float (&rs)[8]) {
    float v[8];
#pragma unroll
    for (int i = 0; i < 8; ++i) v[i] = ssq[row0 + (i >> 2) * HALF + (i & 3) * 16];
#pragma unroll
    for (int i = 0; i < 8; ++i) rs[i] = __builtin_amdgcn_rsqf(v[i] * (1.0f / 1024.0f) + 1e-6f) * cs;
}
struct EpiSwiGLU {
    static constexpr bool PERM = true, AFTER_DRAIN = false;
    bf16_t* O; const float* ssq;
    __device__ __forceinline__ void operator()(const f32x4 (&acc)[2][2][4][2], const Unit& u, int wr, int wc, int fr, int fq) const {
        const int row0 = u.pm * BM + wr * 64 + fr, col0 = u.pn * HALF + wc * 32 + 8 * fq;
        float rs8[8]; rstd8(ssq, row0, 1.0f, rs8);
#pragma unroll
        for (int ai = 0; ai < 2; ++ai)
#pragma unroll
            for (int m = 0; m < 4; ++m) { const int row = row0 + ai * HALF + m * 16; const float rs = rs8[ai * 4 + m];
                const f32x4 g0 = acc[ai][0][m][0] * rs, g1 = acc[ai][0][m][1] * rs, u0 = acc[ai][1][m][0] * rs, u1 = acc[ai][1][m][1] * rs;
                const f32x4 a0 = g0 * -1.4426950408889634f, a1 = g1 * -1.4426950408889634f;
                f32x4 e0, e1, r0, r1;
#pragma unroll
                for (int j = 0; j < 4; ++j) { e0[j] = __builtin_amdgcn_exp2f(a0[j]); e1[j] = __builtin_amdgcn_exp2f(a1[j]); }
                const f32x4 d0 = e0 + 1.0f, d1 = e1 + 1.0f;
#pragma unroll
                for (int j = 0; j < 4; ++j) { r0[j] = __builtin_amdgcn_rcpf(d0[j]); r1[j] = __builtin_amdgcn_rcpf(d1[j]); }
                const f32x4 h0 = (g0 * u0) * r0, h1 = (g1 * u1) * r1;
                u32x4 wv; wv.x = cvt_pk_bf16(h0[0], h0[1]); wv.y = cvt_pk_bf16(h0[2], h0[3]); wv.z = cvt_pk_bf16(h1[0], h1[1]); wv.w = cvt_pk_bf16(h1[2], h1[3]);
                *(u32x4*)(O + (size_t)row * 2816 + col0) = wv; }
    }
};
struct EpiResid {
    static constexpr bool PERM = true, AFTER_DRAIN = false;
    const float* Xin; bf16_t* XH; bf16_t* XL; float* ssq_out; float coef;
    __device__ __forceinline__ void operator()(const f32x4 (&acc)[2][2][4][2], const Unit& u, int wr, int wc, int fr, int fq) const {
        if (Xin != nullptr) body<true>(acc, u, wr, wc, fr, fq); else body<false>(acc, u, wr, wc, fr, fq);
    }
    template <bool f32in> __device__ __forceinline__ void body(const f32x4 (&acc)[2][2][4][2], const Unit& u, int wr, int wc, int fr, int fq) const {
        const int row0 = u.pm * BM + wr * 64 + fr, col0 = u.pn * BM + wc * 32 + 8 * fq;
        const char* xin = (const char*)Xin; char* xh = (char*)XH; char* xl = (char*)XL;
#pragma unroll
        for (int ap = 0; ap < 4; ++ap) { const int ai = ap >> 1, mb = 2 * (ap & 1);
            u32x4 pre[2][2][2];
#pragma unroll
            for (int mm = 0; mm < 2; ++mm) { const unsigned r_ = (unsigned)(row0 + ai * HALF + (mb + mm) * 16);
#pragma unroll
                for (int bj = 0; bj < 2; ++bj) {
                    if (f32in) { const unsigned off = (r_ * 1024u + (unsigned)col0) * 4u + bj * (HALF * 4);
                        pre[mm][bj][0] = __builtin_nontemporal_load((const u32x4*)(xin + off)); pre[mm][bj][1] = __builtin_nontemporal_load((const u32x4*)(xin + off + 16)); }
                    else { pre[mm][bj][0] = *(const u32x4*)(xh + (r_ * 1024u + (unsigned)col0) * 2u + bj * (HALF * 2)); pre[mm][bj][1] = *(const u32x4*)(xl + (r_ * 2048u + (unsigned)col0) * 2u + bj * (HALF * 2)); } } }
#pragma unroll
            for (int mm = 0; mm < 2; ++mm) { const int m = mb + mm; const int row = row0 + ai * HALF + m * 16; float ss = 0.f;
#pragma unroll
                for (int bj = 0; bj < 2; ++bj) { float a[8];
                    if (f32in) {
#pragma unroll
                        for (int e = 0; e < 4; ++e) { a[e] = __uint_as_float(pre[mm][bj][0][e]); a[4 + e] = __uint_as_float(pre[mm][bj][1][e]); } }
                    else {
#pragma unroll
                        for (int e = 0; e < 4; ++e) { const unsigned hw = pre[mm][bj][0][e], lw = pre[mm][bj][1][e];
                            a[2 * e] = __uint_as_float(hw << 16) + __uint_as_float(lw << 16); a[2 * e + 1] = __uint_as_float(hw & 0xffff0000u) + __uint_as_float(lw & 0xffff0000u); } }
#pragma unroll
                    for (int e = 0; e < 4; ++e) { a[e] += acc[ai][bj][m][0][e] * coef; a[4 + e] += acc[ai][bj][m][1][e] * coef; }
                    u32x4 hv, lv;
#pragma unroll
                    for (int e = 0; e < 4; ++e) { ss += a[2 * e] * a[2 * e] + a[2 * e + 1] * a[2 * e + 1];
                        const unsigned hw = cvt_pk_bf16(a[2 * e], a[2 * e + 1]); hv[e] = hw;
                        lv[e] = cvt_pk_bf16(a[2 * e] - __uint_as_float(hw << 16), a[2 * e + 1] - __uint_as_float(hw & 0xffff0000u)); }
                    *(u32x4*)(xh + ((unsigned)row * 1024u + (unsigned)col0) * 2u + bj * (HALF * 2)) = hv;
                    *(u32x4*)(xl + ((unsigned)row * 2048u + (unsigned)col0) * 2u + bj * (HALF * 2)) = lv; }
                ss += __shfl_xor(ss, 16); ss += __shfl_xor(ss, 32);
                if (fq == 0) atomicAdd(ssq_out + row, ss); }
        }
    }
};
struct EpiGeluZ {
    static constexpr bool PERM = true, AFTER_DRAIN = false;
    bf16_t* Z; const float* ssq; float* vsum; float* vsq;
    __device__ __forceinline__ void operator()(const f32x4 (&acc)[2][2][4][2], const Unit& u, int wr, int wc, int fr, int fq) const {
        const int row0 = u.pm * BM + wr * 64 + fr, col0 = u.pn * BM + wc * 32 + 8 * fq; const bool isv = u.pn >= 4;
        float rs8[8]; rstd8(ssq, row0, 1.0f, rs8);
#pragma unroll
        for (int ai = 0; ai < 2; ++ai)
#pragma unroll
            for (int m = 0; m < 4; ++m) { const int row = row0 + ai * HALF + m * 16; const float rs = rs8[ai * 4 + m]; float s1 = 0.f, s2 = 0.f;
                bf16_t* zr = Z + (size_t)row * 2048 + col0;
#pragma unroll
                for (int bj = 0; bj < 2; ++bj) {
                    f32x4 v[2] = {acc[ai][bj][m][0] * rs, acc[ai][bj][m][1] * rs}, t[2], q[2], e[2], o[2];
#pragma unroll
                    for (int h = 0; h < 2; ++h) { const f32x4 d = __builtin_elementwise_abs(v[h]) * 0.2316418882f + 1.0f;
#pragma unroll
                        for (int j = 0; j < 4; ++j) t[h][j] = __builtin_amdgcn_rcpf(d[j]); }
#pragma unroll
                    for (int h = 0; h < 2; ++h) { f32x4 p_ = t[h] * 0.5307027145f + (-0.7265760135f); p_ = p_ * t[h] + 0.7107068705f; p_ = p_ * t[h] + (-0.142248368f); p_ = p_ * t[h] + 0.127414796f; q[h] = p_ * t[h]; }
#pragma unroll
                    for (int h = 0; h < 2; ++h) { const f32x4 sq = (v[h] * v[h]) * (-0.72134752044f);
#pragma unroll
                        for (int j = 0; j < 4; ++j) e[h][j] = __builtin_amdgcn_exp2f(sq[j]); }
#pragma unroll
                    for (int h = 0; h < 2; ++h) { const f32x4 mm_ = v[h] * (q[h] * e[h]), rr_ = v[h] - mm_;
#pragma unroll
                        for (int j = 0; j < 4; ++j) o[h][j] = v[h][j] < 0.f ? mm_[j] : rr_[j]; }
#pragma unroll
                    for (int h = 0; h < 2; ++h) { s1 += (o[h][0] + o[h][1]) + (o[h][2] + o[h][3]); s2 += (o[h][0] * o[h][0] + o[h][1] * o[h][1]) + (o[h][2] * o[h][2] + o[h][3] * o[h][3]); }
                    u32x4 w; w.x = cvt_pk_bf16(o[0][0], o[0][1]); w.y = cvt_pk_bf16(o[0][2], o[0][3]); w.z = cvt_pk_bf16(o[1][0], o[1][1]); w.w = cvt_pk_bf16(o[1][2], o[1][3]);
                    *(u32x4*)(zr + bj * HALF) = w; }
                if (isv) { s1 += __shfl_xor(s1, 16); s1 += __shfl_xor(s1, 32); s2 += __shfl_xor(s2, 16); s2 += __shfl_xor(s2, 32);
                    if (fq == 0) { atomicAdd(vsum + row, s1); atomicAdd(vsq + row, s2); } } }
    }
};
struct EpiScale {
    static constexpr bool PERM = true, AFTER_DRAIN = false;
    bf16_t* O; const float* ssq; float cs;
    __device__ __forceinline__ void operator()(const f32x4 (&acc)[2][2][4][2], const Unit& u, int wr, int wc, int fr, int fq) const {
        const int row0 = u.pm * BM + wr * 64 + fr, col0 = u.pn * BM + wc * 32 + 8 * fq;
        float rs8[8]; rstd8(ssq, row0, cs, rs8);
#pragma unroll
        for (int ai = 0; ai < 2; ++ai)
#pragma unroll
            for (int m = 0; m < 4; ++m) { const int row = row0 + ai * HALF + m * 16; const float rs = rs8[ai * 4 + m];
                bf16_t* orow = O + (size_t)row * 1024 + col0;
#pragma unroll
                for (int bj = 0; bj < 2; ++bj) { const f32x4 v0 = acc[ai][bj][m][0] * rs, v1 = acc[ai][bj][m][1] * rs;
                    u32x4 w; w.x = cvt_pk_bf16(v0[0], v0[1]); w.y = cvt_pk_bf16(v0[2], v0[3]); w.z = cvt_pk_bf16(v1[0], v1[1]); w.w = cvt_pk_bf16(v1[2], v1[3]);
                    *(u32x4*)(orow + bj * HALF) = w; } }
    }
};
struct EpiScaleCol {
    static constexpr bool PERM = true, AFTER_DRAIN = false;
    bf16_t* O; const float* ssq; int ldc;
    __device__ __forceinline__ void operator()(const f32x4 (&acc)[2][2][4][2], const Unit& u, int wr, int wc, int fr, int fq) const {
        const int row0 = u.pm * BM + wr * 64 + fr, col0 = u.pn * BM + wc * 32 + 8 * fq;
        f32x4 rs[2][2];
#pragma unroll
        for (int bj = 0; bj < 2; ++bj)
#pragma unroll
            for (int n = 0; n < 2; ++n) { const f32x4 s = *(const f32x4*)(ssq + col0 + bj * HALF + 4 * n);
#pragma unroll
                for (int j = 0; j < 4; ++j) rs[bj][n][j] = __builtin_amdgcn_rsqf(s[j] * (1.0f / 1024.0f) + 1e-6f); }
#pragma unroll
        for (int ai = 0; ai < 2; ++ai)
#pragma unroll
            for (int m = 0; m < 4; ++m) { const int row = row0 + ai * HALF + m * 16; bf16_t* orow = O + (size_t)row * ldc + col0;
#pragma unroll
                for (int bj = 0; bj < 2; ++bj) { const f32x4 v0 = acc[ai][bj][m][0] * rs[bj][0], v1 = acc[ai][bj][m][1] * rs[bj][1];
                    u32x4 w; w.x = cvt_pk_bf16(v0[0], v0[1]); w.y = cvt_pk_bf16(v0[2], v0[3]); w.z = cvt_pk_bf16(v1[0], v1[1]); w.w = cvt_pk_bf16(v1[2], v1[3]);
                    *(u32x4*)(orow + bj * HALF) = w; } }
    }
};
template <class Epi, class Sched, bool ALIGN_EPI = false, bool SP2 = false>
__device__ __forceinline__ void gemm_phase(PG8_LAS unsigned char* lds, const Gemm g, const Sched& S, const Epi& E) {
    int tid_l = threadIdx.x; asm volatile("" : "+v"(tid_l));
    const int tid = tid_l, wid = __builtin_amdgcn_readfirstlane(tid >> 6), lane = tid & 63, wr = wid >> 2, wc = wid & 3, fr = lane & 15, fq = lane >> 4;
    const int K = g.K, nt = K / BK;
    unsigned voffA[2], voffB[2];
#pragma unroll
    for (int i = 0; i < 2; ++i) { int R, C; stage_rc(tid * 16 + i * 8192, R, C); const int Rb = Epi::PERM ? ((R & ~31) + perm32(R & 31)) : R;
        voffA[i] = (unsigned)(R * K + C) * 2u; voffB[i] = (unsigned)(Rb * K + C) * 2u; }
    const size_t kstep = (size_t)(BK * 2);
    const size_t hstep = (size_t)HALF * K * 2;
    const size_t tstep = 2 * hstep;
    const unsigned ldsw = (unsigned)wid * 1024u;
    const int aoff = lds_byte(wr * 64 + fr, fq * 8), boff = lds_byte(wc * 32 + fr, fq * 8);
#define PG8_SA(b, h) (((b) * 2 + (h)) * HTB)
#define PG8_SB(b, h) ((4 + (b) * 2 + (h)) * HTB)
#define PG8_STAGE(bufoff, gbase, voff) do { _Pragma("unroll") for (int _i = 0; _i < 2; ++_i) \
        __builtin_amdgcn_global_load_lds((const unsigned*)((const char*)(gbase) + (voff)[_i]), (PG8_LAS unsigned*)(lds + (bufoff) + ldsw + _i * 8192), 16, 0, 0); } while (0)
#define PG8_LDA(dst, b, h) do { _Pragma("unroll") for (int m = 0; m < 4; ++m) _Pragma("unroll") for (int k = 0; k < 2; ++k) dst[m][k] = *(const PG8_LAS bf16x8*)(lds + PG8_SA(b, h) + aoff + m * 2048 + k * 1024); } while (0)
#define PG8_LDB(dst, b, h) do { _Pragma("unroll") for (int n = 0; n < 2; ++n) _Pragma("unroll") for (int k = 0; k < 2; ++k) dst[n][k] = *(const PG8_LAS bf16x8*)(lds + PG8_SB(b, h) + boff + n * 2048 + k * 1024); } while (0)
#define PG8_MMA(ai, bj, At, Bt) do { __builtin_amdgcn_s_setprio(1); _Pragma("unroll") for (int m = 0; m < 4; ++m) _Pragma("unroll") for (int n = 0; n < 2; ++n) _Pragma("unroll") for (int k = 0; k < 2; ++k) \
        acc[ai][bj][m][n] = __builtin_amdgcn_mfma_f32_16x16x32_bf16(Bt[n][k], At[m][k], acc[ai][bj][m][n], 0, 0, 0); __builtin_amdgcn_s_setprio(0); } while (0)
#define PG8_WAIT_V(n) asm volatile("s_waitcnt vmcnt(" #n ")" ::: "memory")
#define PG8_WAIT_L(n) asm volatile("s_waitcnt lgkmcnt(" #n ")" ::: "memory")
#define PG8_BAR __builtin_amdgcn_s_barrier()
#define PG8_SCHED __builtin_amdgcn_sched_barrier(0)
    Unit cur, nxt; int ui = 0;
    if (!S.next(0, cur)) return;
    f32x4 acc[2][2][4][2];
#pragma unroll
    for (int a = 0; a < 2; ++a)
#pragma unroll
        for (int b = 0; b < 2; ++b)
#pragma unroll
            for (int m = 0; m < 4; ++m)
#pragma unroll
                for (int n = 0; n < 2; ++n) acc[a][b][m][n] = (f32x4){0.f, 0.f, 0.f, 0.f};
    bf16x8 At[4][2], B0[2][2], B1[2][2];
    const char* cA = (const char*)g.A + (size_t)cur.pm * tstep; const char* cB = (const char*)g.Bt + (size_t)cur.pn * tstep;
    S.a_ready(cur);
    if constexpr (SP2) {
        PG8_STAGE(PG8_SB(0, 0), cB, voffB); PG8_STAGE(PG8_SB(0, 1), cB + hstep, voffB); PG8_STAGE(PG8_SA(0, 0), cA, voffA); PG8_STAGE(PG8_SA(0, 1), cA + hstep, voffA);
        if (wr == 1) PG8_BAR;
        PG8_WAIT_V(2); PG8_BAR;
        PG8_STAGE(PG8_SB(1, 0), cB + kstep, voffB); PG8_STAGE(PG8_SA(1, 0), cA + kstep, voffA); PG8_STAGE(PG8_SB(1, 1), cB + hstep + kstep, voffB);
        PG8_WAIT_V(6); PG8_BAR;
    } else {
        PG8_STAGE(PG8_SB(0, 0), cB, voffB); PG8_STAGE(PG8_SA(0, 0), cA, voffA); PG8_STAGE(PG8_SB(0, 1), cB + hstep, voffB); PG8_STAGE(PG8_SA(0, 1), cA + hstep, voffA);
        if (wr == 1) PG8_BAR;
        PG8_WAIT_V(4); PG8_BAR;
        PG8_STAGE(PG8_SB(1, 0), cB + kstep, voffB); PG8_STAGE(PG8_SA(1, 0), cA + kstep, voffA); PG8_STAGE(PG8_SB(1, 1), cB + hstep + kstep, voffB);
        PG8_WAIT_V(6); PG8_BAR;
    }
    for (;;) {
        const bool has_next = S.next(ui + 1, nxt);
        const char* nA = has_next ? (const char*)g.A + (size_t)nxt.pm * tstep : cA; const char* nB = has_next ? (const char*)g.Bt + (size_t)nxt.pn * tstep : cB;
        for (int t = 0; t < nt; t += 2) {
            const bool last = (t == nt - 2);
            const char* a1 = cA + (size_t)(t + 1) * kstep;
            const char* a2 = last ? nA : cA + (size_t)(t + 2) * kstep; const char* b2 = last ? nB : cB + (size_t)(t + 2) * kstep;
            const char* a3 = a2 + kstep; const char* b3 = b2 + kstep;
            if (last && has_next) S.a_ready(nxt);
            if constexpr (SP2) {
            PG8_LDB(B0, 0, 0); PG8_LDB(B1, 0, 1); PG8_SCHED; PG8_LDA(At, 0, 0); PG8_STAGE(PG8_SA(1, 1), a1 + hstep, voffA);
            PG8_WAIT_V(8); PG8_WAIT_L(0); PG8_BAR; PG8_MMA(0, 0, At, B0); PG8_MMA(0, 1, At, B1); PG8_BAR; PG8_SCHED;
            PG8_LDA(At, 0, 1); PG8_STAGE(PG8_SB(0, 0), b2, voffB); PG8_STAGE(PG8_SB(0, 1), b2 + hstep, voffB); PG8_STAGE(PG8_SA(0, 0), a2, voffA);
            PG8_WAIT_V(8); PG8_WAIT_L(0); PG8_BAR; PG8_MMA(1, 0, At, B0); PG8_MMA(1, 1, At, B1); PG8_BAR; PG8_SCHED;
            PG8_LDB(B0, 1, 0); PG8_LDB(B1, 1, 1); PG8_SCHED; PG8_LDA(At, 1, 0); PG8_STAGE(PG8_SA(0, 1), a2 + hstep, voffA);
            PG8_WAIT_V(8); PG8_WAIT_L(0); PG8_BAR; PG8_MMA(0, 0, At, B0); PG8_MMA(0, 1, At, B1); PG8_BAR; PG8_SCHED;
            PG8_LDA(At, 1, 1); PG8_STAGE(PG8_SB(1, 0), b3, voffB); PG8_STAGE(PG8_SB(1, 1), b3 + hstep, voffB); PG8_STAGE(PG8_SA(1, 0), a3, voffA);
            PG8_WAIT_V(8); PG8_WAIT_L(0); PG8_BAR; PG8_MMA(1, 0, At, B0); PG8_MMA(1, 1, At, B1); PG8_BAR; PG8_SCHED;
            } else {
            PG8_LDB(B0, 0, 0); PG8_SCHED; PG8_LDA(At, 0, 0); PG8_STAGE(PG8_SA(1, 1), a1 + hstep, voffA);
            PG8_WAIT_L(8); PG8_BAR; PG8_WAIT_L(0); PG8_MMA(0, 0, At, B0); PG8_BAR; PG8_SCHED;
            PG8_LDB(B1, 0, 1); PG8_STAGE(PG8_SB(0, 0), b2, voffB);
            PG8_BAR; PG8_WAIT_L(0); PG8_MMA(0, 1, At, B1); PG8_BAR;
            PG8_LDA(At, 0, 1); PG8_STAGE(PG8_SA(0, 0), a2, voffA);
            PG8_BAR; PG8_WAIT_L(0); PG8_MMA(1, 0, At, B0); PG8_BAR; PG8_SCHED;
            PG8_STAGE(PG8_SB(0, 1), b2 + hstep, voffB);
            PG8_WAIT_V(6); PG8_BAR; PG8_MMA(1, 1, At, B1); PG8_BAR;
            PG8_LDB(B0, 1, 0); PG8_SCHED; PG8_LDA(At, 1, 0); PG8_STAGE(PG8_SA(0, 1), a2 + hstep, voffA);
            PG8_WAIT_L(8); PG8_BAR; PG8_WAIT_L(0); PG8_MMA(0, 0, At, B0); PG8_BAR; PG8_SCHED;
            PG8_LDB(B1, 1, 1); PG8_STAGE(PG8_SB(1, 0), b3, voffB);
            PG8_BAR; PG8_WAIT_L(0); PG8_MMA(0, 1, At, B1); PG8_BAR;
            PG8_LDA(At, 1, 1); PG8_STAGE(PG8_SA(1, 0), a3, voffA);
            PG8_BAR; PG8_WAIT_L(0); PG8_MMA(1, 0, At, B0); PG8_BAR; PG8_SCHED;
            PG8_STAGE(PG8_SB(1, 1), b3 + hstep, voffB);
            PG8_WAIT_V(6); PG8_BAR; PG8_MMA(1, 1, At, B1); PG8_BAR;
            }
        }
        if constexpr (ALIGN_EPI) { if (wr == 0) PG8_BAR; }
        if constexpr (!Epi::AFTER_DRAIN) { E(acc, cur, wr, wc, fr, fq); S.done(cur); }
        if (!has_next) break;
#pragma unroll
        for (int a = 0; a < 2; ++a)
#pragma unroll
            for (int b = 0; b < 2; ++b)
#pragma unroll
                for (int m = 0; m < 4; ++m)
#pragma unroll
                    for (int n = 0; n < 2; ++n) acc[a][b][m][n] = (f32x4){0.f, 0.f, 0.f, 0.f};
        cur = nxt; cA = nA; cB = nB; ++ui;
        if constexpr (ALIGN_EPI) { if (wr == 1) PG8_BAR; }
    }
    PG8_WAIT_V(0);
    if constexpr (!ALIGN_EPI) { if (wr == 0) PG8_BAR; }
    PG8_BAR;
    if constexpr (Epi::AFTER_DRAIN) { E.fused(acc, cur, wr, wc, fr, fq, lds, wid, lane); S.done(cur); }
#undef PG8_SA
#undef PG8_SB
#undef PG8_STAGE
#undef PG8_LDA
#undef PG8_LDB
#undef PG8_MMA
#undef PG8_WAIT_V
#undef PG8_WAIT_L
#undef PG8_BAR
#undef PG8_SCHED
}
}

#define LAS __attribute__((address_space(3)))
typedef unsigned short bf16;
typedef short bf16x8 __attribute__((ext_vector_type(8)));
typedef float f32x4 __attribute__((ext_vector_type(4)));
typedef float f32x16 __attribute__((ext_vector_type(16)));
typedef unsigned u32x4 __attribute__((ext_vector_type(4)));
typedef unsigned u32x2 __attribute__((ext_vector_type(2)));
constexpr int NB = 2, SEQ = 16384, T = NB * SEQ, D = 1024, FF = 2816, NH = 8;
constexpr float LOG2E = 1.4426950408889634f;
constexpr float LAMBDA_INIT = 0.35550906759f;
constexpr float QSCALE = 0.125f * LOG2E;
constexpr size_t MiB = 1u << 20;
constexpr size_t WS_SMALL = 0;
constexpr size_t WS_XBAR = 1600000;
constexpr size_t WS_WGU = 2 * MiB, WGU_BYTES = (size_t)2 * FF * D * 2;
constexpr size_t WS_WDN = 46 * MiB, WDN_BYTES = (size_t)D * FF * 2;
constexpr size_t WS_WIN = 68 * MiB, WS_WOUT = 72 * MiB, WS_WK = 74 * MiB, WS_WV = 76 * MiB, WS_WQ = 78 * MiB, WS_WO = 80 * MiB;
constexpr size_t WS_XB = 82 * MiB;
constexpr size_t WS_ACT = 146 * MiB;
constexpr size_t WS_KB = 322 * MiB;
constexpr size_t WS_VT = 386 * MiB;
constexpr size_t WS_END = 450 * MiB;
static_assert(WS_WGU + 4 * WGU_BYTES <= WS_WDN && WS_WDN + 4 * WDN_BYTES <= WS_WIN && WS_ACT + (size_t)T * FF * 2 <= WS_KB, "ws map");
constexpr int LDS_BYTES = 135168;
constexpr int LDS_CTL = 131072;

__device__ __forceinline__ unsigned pk2(float lo, float hi) { return pg8::cvt_pk_bf16(lo, hi); }
__device__ __forceinline__ unsigned f2bf(float f) { return pg8::cvt_pk_bf16(f, f) & 0xffffu; }
__device__ __forceinline__ float bf2f(unsigned short b) { return __builtin_bit_cast(float, (unsigned)b << 16); }
__device__ __forceinline__ float wave_sum(float v) {
#pragma unroll
    for (int o = 1; o < 64; o <<= 1) v += __shfl_xor(v, o);
    return v;
}
__device__ __forceinline__ float swap_max(float v) { auto rr = __builtin_amdgcn_permlane32_swap(__float_as_uint(v), __float_as_uint(v), false, false); return fmaxf(__uint_as_float(rr[0]), __uint_as_float(rr[1])); }
__device__ __forceinline__ float swap_sum(float v) { auto rr = __builtin_amdgcn_permlane32_swap(__float_as_uint(v), __float_as_uint(v), false, false); return __uint_as_float(rr[0]) + __uint_as_float(rr[1]); }

struct Params { const float* in[27]; float* out; unsigned char* ws; };

#define XB_TMO      128
#define XB_XCNT(j)  (256  + 64 * (j))
#define XB_XSUB(j)  (1280 + 64 * (j))
#define XB_XGEN(j)  (2304 + 64 * (j))
#define XB_TOP      3328
#define XB_TOPGEN   3392
#define XCD_BAR_WORDS 3456
#define XB_SPIN_CAP (1u << 18)

__device__ __forceinline__ unsigned xb_ld(unsigned* p)              { return __hip_atomic_load(p, __ATOMIC_RELAXED, __HIP_MEMORY_SCOPE_AGENT); }
__device__ __forceinline__ unsigned xb_add(unsigned* p, unsigned v) { return __hip_atomic_fetch_add(p, v, __ATOMIC_RELAXED, __HIP_MEMORY_SCOPE_AGENT); }
__device__ __forceinline__ unsigned xb_xcc_id() { return (unsigned)__builtin_amdgcn_s_getreg((3 << 11) | 20) & 0xFu; }
#define XB_SPIN(cond, bar) do { unsigned _sp = 0; while (cond) { __builtin_amdgcn_s_sleep(1); \
    if ((++_sp & 255u) == 0u) { if (xb_ld(&(bar)[XB_TMO])) break; if (_sp > XB_SPIN_CAP) { atomicAdd(&(bar)[XB_TMO], 1u); break; } } } } while (0)

struct XcdBarrier {
    unsigned* bar; unsigned x;
    volatile LAS unsigned* st;
};

__device__ __forceinline__ XcdBarrier xcd_barrier_post(unsigned* bar, volatile LAS unsigned* st) {
    XcdBarrier b; b.bar = bar; b.x = xb_xcc_id(); b.st = st;
    if (threadIdx.x == 0) (void)xb_add(&bar[XB_XCNT(b.x)], 1u);
    return b;
}
__device__ __forceinline__ void xcd_barrier_complete(unsigned* bar, unsigned x, unsigned& nloc, unsigned& nx) {
    const unsigned G = gridDim.x * gridDim.y * gridDim.z;
    unsigned sum, cnt, mine, sp = 0u;
    for (;;) {
        sum = 0u; cnt = 0u; mine = 0u;
#pragma unroll
        for (unsigned j = 0; j < 16; ++j) { const unsigned c = xb_ld(&bar[XB_XCNT(j)]); sum += c; cnt += (c > 0u) ? 1u : 0u; mine = (j == x) ? c : mine; }
        if (sum == G) break;
        __builtin_amdgcn_s_sleep(1);
        if ((++sp & 255u) == 0u) { if (xb_ld(&bar[XB_TMO])) break; if (sp > XB_SPIN_CAP) { atomicAdd(&bar[XB_TMO], 1u); break; } }
    }
    nloc = mine > 0u ? mine : 1u; nx = cnt > 0u ? cnt : 1u;
}

__device__ __forceinline__ void xcd_barrier(const XcdBarrier& b) {
    asm volatile("s_waitcnt vmcnt(0)" ::: "memory");
    __syncthreads();
    if (threadIdx.x == 0) {
        unsigned* bar = b.bar;
        __builtin_amdgcn_s_waitcnt(0);
        unsigned nloc = b.st[0], nx = b.st[1];
        if (nloc == 0u) { xcd_barrier_complete(bar, b.x, nloc, nx); b.st[0] = nloc; b.st[1] = nx; }
        const unsigned old = xb_add(&bar[XB_XSUB(b.x)], 1u);
        const unsigned gen = old / nloc;
        if (old + 1u == (gen + 1u) * nloc) {
            __builtin_amdgcn_fence(__ATOMIC_RELEASE, "agent");
            asm volatile("s_waitcnt vmcnt(0)" ::: "memory");
            const unsigned og = xb_add(&bar[XB_TOP], 1u);
            const unsigned tg = og / nx;
            if (og + 1u == (tg + 1u) * nx) xb_add(&bar[XB_TOPGEN], 1u);
            else XB_SPIN(xb_ld(&bar[XB_TOPGEN]) == tg, bar);
            __builtin_amdgcn_fence(__ATOMIC_ACQUIRE, "agent");
            xb_add(&bar[XB_XGEN(b.x)], 1u);
            asm volatile("s_waitcnt vmcnt(0)" ::: "memory");
        } else {
            XB_SPIN(xb_ld(&bar[XB_XGEN(b.x)]) == gen, bar);
            __builtin_amdgcn_fence(__ATOMIC_ACQUIRE, "agent");
            asm volatile("s_waitcnt vmcnt(0)" ::: "memory");
        }
    }
    __syncthreads();
}
__device__ __forceinline__ void transpose_item(const float* W, int K, int N, bf16* WT, int mode, const float* gk, int gmask, float gmul, LAS float* scr, int item, int lane) {
    const int nblk = N / 32, kb = item / nblk, nb = item % nblk, k0 = 64 * kb, n0 = 32 * nb;
    const int n4 = (lane & 7) * 4, kr = lane >> 3;
    f32x4 v[8];
#pragma unroll
    for (int i = 0; i < 8; ++i) v[i] = __builtin_nontemporal_load((const f32x4*)(W + (size_t)(k0 + 8 * i + kr) * N + n0 + n4));
    if (gk) {
#pragma unroll
        for (int i = 0; i < 8; ++i) v[i] = v[i] * (gk[(k0 + 8 * i + kr) & gmask] * gmul);
    }
#pragma unroll
    for (int i = 0; i < 8; ++i) { LAS float* d = scr + (8 * i + kr) * 33 + n4; d[0] = v[i][0]; d[1] = v[i][1]; d[2] = v[i][2]; d[3] = v[i][3]; }
    asm volatile("s_waitcnt lgkmcnt(0)" ::: "memory");
    const int c = lane & 7;
    int nbase = n0; if (mode != 0) nbase = (n0 >> 7) * 256 + (n0 & 127) + (mode == 2 ? 128 : 0);
#pragma unroll
    for (int j = 0; j < 4; ++j) { const int n = (lane >> 3) + 8 * j; const LAS float* s = scr + (8 * c) * 33 + n;
        u32x4 o; o.x = pk2(s[0 * 33], s[1 * 33]); o.y = pk2(s[2 * 33], s[3 * 33]); o.z = pk2(s[4 * 33], s[5 * 33]); o.w = pk2(s[6 * 33], s[7 * 33]);
        *(u32x4*)(WT + (size_t)(nbase + n) * K + k0 + 8 * c) = o; }
    asm volatile("s_waitcnt lgkmcnt(0)" ::: "memory");
}
__device__ __forceinline__ void prologue(const Params& p, LAS unsigned char* lds, int G, int bid, int tid) {
    asm volatile("" : "+v"(tid)); asm volatile("" : "+s"(G), "+s"(bid));
    const int lane = tid & 63, wave = tid >> 6;
    LAS float* scr = (LAS float*)(lds + wave * 16384);
    const int gw = bid * 8 + wave, NGW = G * 8;
    unsigned char* ws = p.ws;
    float* small = (float*)(ws + WS_SMALL);
#pragma unroll 1
    for (int i = bid * 512 + tid; i < 8 * T + 64; i += G * 512) small[T + i] = 0.f;
    const float* x = p.in[0]; bf16* xb = (bf16*)(ws + WS_XB);
#pragma unroll 1
    for (int m = gw; m < T; m += 2 * NGW) {
        const int m2 = m + NGW;
        const bool has2 = m2 < T;
        const f32x4* xr = (const f32x4*)(x + (size_t)m * D) + lane; const f32x4* xr2 = (const f32x4*)(x + (size_t)(has2 ? m2 : m) * D) + lane;
        f32x4 v[4], v2[4]; float s = 0.f, s2 = 0.f;
#pragma unroll
        for (int j = 0; j < 4; ++j) { v[j] = __builtin_nontemporal_load(xr + 64 * j); v2[j] = __builtin_nontemporal_load(xr2 + 64 * j); }
#pragma unroll
        for (int j = 0; j < 4; ++j) { s += (v[j][0] * v[j][0] + v[j][1] * v[j][1]) + (v[j][2] * v[j][2] + v[j][3] * v[j][3]); s2 += (v2[j][0] * v2[j][0] + v2[j][1] * v2[j][1]) + (v2[j][2] * v2[j][2] + v2[j][3] * v2[j][3]); }
        s = wave_sum(s); s2 = wave_sum(s2);
        u32x2* brow = (u32x2*)(xb + (size_t)m * D) + lane; u32x2* brow2 = (u32x2*)(xb + (size_t)m2 * D) + lane;
#pragma unroll
        for (int j = 0; j < 4; ++j) { u32x2 w; w.x = pk2(v[j][0], v[j][1]); w.y = pk2(v[j][2], v[j][3]); brow[64 * j] = w;
            if (has2) { u32x2 w2; w2.x = pk2(v2[j][0], v2[j][1]); w2.y = pk2(v2[j][2], v2[j][3]); brow2[64 * j] = w2; } }
        if (lane == 0) { small[m] = s; if (has2) small[m2] = s2; }
    }
    constexpr int I_F = 1408, N_FFN = 12 * I_F, I_IN = 1024, I_SQ = 512;
    constexpr int NITEMS = N_FFN + I_IN + 5 * I_SQ;
#pragma unroll 1
    for (int it = gw; it < NITEMS; it += NGW) {
        if (it < N_FFN) {
            const int mid = it / I_F, r = it % I_F, f = mid / 3, kind = mid % 3, l = f >> 1, second = f & 1;
            const float* g = p.in[second ? 6 : 1] + l * D;
            if (kind == 0)      transpose_item(p.in[second ? 7 : 2] + (size_t)l * D * FF, D, FF, (bf16*)(ws + WS_WGU + f * WGU_BYTES), 1, g, 1023, 1.f, scr, r, lane);
            else if (kind == 1) transpose_item(p.in[second ? 8 : 3] + (size_t)l * D * FF, D, FF, (bf16*)(ws + WS_WGU + f * WGU_BYTES), 2, g, 1023, 1.f, scr, r, lane);
            else                transpose_item(p.in[second ? 9 : 4] + (size_t)l * D * FF, FF, D, (bf16*)(ws + WS_WDN + f * WDN_BYTES), 0, nullptr, 0, 1.f, scr, r, lane);
        } else {
            int r = it - N_FFN;
            if (r < I_IN) { transpose_item(p.in[10], D, 2 * D, (bf16*)(ws + WS_WIN), 0, p.in[5], 1023, 1.f, scr, r, lane); continue; }
            r -= I_IN; const int mid = r / I_SQ; r = r % I_SQ;
            if (mid == 0)      transpose_item(p.in[15], D, D, (bf16*)(ws + WS_WOUT), 0, nullptr, 0, 1.f, scr, r, lane);
            else if (mid == 1) transpose_item(p.in[17], D, D, (bf16*)(ws + WS_WK), 0, p.in[16], 1023, 1.f, scr, r, lane);
            else if (mid == 2) transpose_item(p.in[18], D, D, (bf16*)(ws + WS_WV), 0, p.in[16], 1023, 1.f, scr, r, lane);
            else if (mid == 3) transpose_item(p.in[19], D, D, (bf16*)(ws + WS_WQ), 0, p.in[5] + D, 1023, 1.f, scr, r, lane);
            else               transpose_item(p.in[25], D, D, (bf16*)(ws + WS_WO), 0, p.in[24], 127, 1.0f - LAMBDA_INIT, scr, r, lane);
        }
    }
}

__device__ __forceinline__ void spatial_phase(const Params& p, LAS unsigned char* lds, int G, int bid, int tid) {
    asm volatile("" : "+v"(tid)); asm volatile("" : "+s"(G), "+s"(bid));
    const int lane = tid & 63, w = tid >> 6, r32 = lane & 31, hi = lane >> 5;
    unsigned char* ws = p.ws;
    const bf16* Z = (const bf16*)(ws + WS_ACT); bf16* Gt = (bf16*)(ws + WS_KB);
    const float* small = (const float*)(ws + WS_SMALL); const float* vsum = small + 7 * T; const float* vsq = small + 8 * T;
    const float* wsp = p.in[13]; const float* bsp = p.in[14]; const float* lng = p.in[11]; const float* lnb = p.in[12];
    LAS unsigned char* As = lds; LAS unsigned char* Bs = lds + 34816;
    const int s = tid & 127, cq = tid >> 7;
    const int tr = 32 * (w & 3), cc = 64 * (w >> 2), nks = 2 * (w & 3) + 2;
    int cur_g = -1;
    u32x4 braw[4]; float bsum = 0.f, bsq = 0.f;
#define SP_LOADB(unit_) do { const int n_ = (unit_) >> 3, g_ = (unit_) & 7; const bf16* zr_ = Z + (size_t)(n_ * 128 + s) * 2048 + 1024 + g_ * 128 + cq * 8; \
        _Pragma("unroll") for (int j = 0; j < 4; ++j) braw[j] = *(const u32x4*)(zr_ + 32 * j); bsum = vsum[n_ * 128 + s]; bsq = vsq[n_ * 128 + s]; } while (0)
    if (bid < 2048) SP_LOADB(bid);
    for (int unit = bid; unit < 2048; unit += G) {
        const int n = unit >> 3, g = unit & 7, t0 = n * 128;
        if (g != cur_g) {
            cur_g = g;
#pragma unroll
            for (int j = 0; j < 8; ++j) { const int c = tid + 512 * j, t = c >> 5, s4 = (c & 31) * 4;
                f32x4 v = *(const f32x4*)(wsp + (size_t)g * 16384 + t * 128 + s4);
#pragma unroll
                for (int e = 0; e < 4; ++e) if (s4 + e > t) v[e] = 0.f;
                u32x2 o; o.x = pk2(v[0], v[1]); o.y = pk2(v[2], v[3]);
                *(LAS u32x2*)(As + t * 272 + s4 * 2) = o; }
        }
        { const float mu = bsum * (1.0f / 1024.0f); const float var = bsq * (1.0f / 1024.0f) - mu * mu; const float rstd = 1.0f / sqrtf(fmaxf(var, 0.f) + 1e-5f);
#pragma unroll
          for (int j = 0; j < 4; ++j) { const int c8 = (cq + 4 * j) * 8;
            const f32x4 g0 = *(const f32x4*)(lng + g * 128 + c8), g1 = *(const f32x4*)(lng + g * 128 + c8 + 4), b0 = *(const f32x4*)(lnb + g * 128 + c8), b1 = *(const f32x4*)(lnb + g * 128 + c8 + 4);
#pragma unroll
            for (int e = 0; e < 8; ++e) { const unsigned wd = braw[j][e >> 1]; const float val = bf2f((unsigned short)((e & 1) ? (wd >> 16) : (wd & 0xffffu)));
                const float gg = e < 4 ? g0[e & 3] : g1[e & 3], bb = e < 4 ? b0[e & 3] : b1[e & 3];
                *(LAS unsigned short*)(Bs + (c8 + e) * 272 + s * 2) = (unsigned short)f2bf((val - mu) * rstd * gg + bb); } } }
        __syncthreads();
        if (unit + G < 2048) SP_LOADB(unit + G);
        const int t = tr + r32;
        const bf16* up = Z + (size_t)(t0 + t) * 2048 + g * 128 + cc + 4 * hi;
        u32x2 uu[2][4];
#pragma unroll
        for (int blk = 0; blk < 2; ++blk)
#pragma unroll
            for (int g4 = 0; g4 < 4; ++g4) uu[blk][g4] = *(const u32x2*)(up + 32 * blk + 8 * g4);
        const float bias = bsp[g * 128 + t];
        f32x16 d0 = {}, d1 = {};
        for (int ks = 0; ks < nks; ++ks) {
            const bf16x8 a = *(const LAS bf16x8*)(As + (tr + r32) * 272 + (16 * ks + 8 * hi) * 2);
            const bf16x8 b0 = *(const LAS bf16x8*)(Bs + (cc + r32) * 272 + (16 * ks + 8 * hi) * 2);
            const bf16x8 b1 = *(const LAS bf16x8*)(Bs + (cc + 32 + r32) * 272 + (16 * ks + 8 * hi) * 2);
            d0 = __builtin_amdgcn_mfma_f32_32x32x16_bf16(b0, a, d0, 0, 0, 0);
            d1 = __builtin_amdgcn_mfma_f32_32x32x16_bf16(b1, a, d1, 0, 0, 0);
        }
        bf16* gp = Gt + (size_t)(t0 + t) * 1024 + g * 128 + cc + 4 * hi;
#pragma unroll
        for (int g4 = 0; g4 < 4; ++g4) {
            { const unsigned u0 = uu[0][g4].x, u1 = uu[0][g4].y; u32x2 o;
              o.x = pk2(__uint_as_float(u0 << 16) * (d0[4 * g4] + bias), __uint_as_float(u0 & 0xffff0000u) * (d0[4 * g4 + 1] + bias));
              o.y = pk2(__uint_as_float(u1 << 16) * (d0[4 * g4 + 2] + bias), __uint_as_float(u1 & 0xffff0000u) * (d0[4 * g4 + 3] + bias));
              *(u32x2*)(gp + 8 * g4) = o; }
            { const unsigned u0 = uu[1][g4].x, u1 = uu[1][g4].y; u32x2 o;
              o.x = pk2(__uint_as_float(u0 << 16) * (d1[4 * g4] + bias), __uint_as_float(u0 & 0xffff0000u) * (d1[4 * g4 + 1] + bias));
              o.y = pk2(__uint_as_float(u1 << 16) * (d1[4 * g4 + 2] + bias), __uint_as_float(u1 & 0xffff0000u) * (d1[4 * g4 + 3] + bias));
              *(u32x2*)(gp + 32 + 8 * g4) = o; }
        }
        __syncthreads();
    }
#undef SP_LOADB
}

__device__ __forceinline__ void knorm_pass(const Params& p, int G, int bid, int tid) {
    asm volatile("" : "+v"(tid)); asm volatile("" : "+s"(G), "+s"(bid));
    const int lane = tid & 63, wave = tid >> 6; const int gw = bid * 8 + wave, NGW = G * 8;
    const bf16* Kb = (const bf16*)(p.ws + WS_KB); unsigned* knmax = (unsigned*)(p.ws + WS_SMALL) + 9 * T + 16;
    float mx0 = 0.f, mx1 = 0.f;
    for (int m = gw; m < T; m += NGW) {
        const u32x4* kr = (const u32x4*)(Kb + (size_t)m * 1024) + 2 * lane;
        const u32x4 a = kr[0], c = kr[1]; float s = 0.f;
#pragma unroll
        for (int e = 0; e < 4; ++e) { const float a0 = __uint_as_float(a[e] << 16), a1 = __uint_as_float(a[e] & 0xffff0000u), c0 = __uint_as_float(c[e] << 16), c1 = __uint_as_float(c[e] & 0xffff0000u);
            s += (a0 * a0 + a1 * a1) + (c0 * c0 + c1 * c1); }
        s += __shfl_xor(s, 1); s += __shfl_xor(s, 2);
        if (m < SEQ) mx0 = fmaxf(mx0, s); else mx1 = fmaxf(mx1, s);
    }
    if ((lane & 3) == 0) { atomicMax(knmax + (lane >> 2), __float_as_uint(mx0)); atomicMax(knmax + 16 + (lane >> 2), __float_as_uint(mx1)); }
}

constexpr int AT_KS = 64 * 272, AT_VS = 128 * 144, AT_STAGE = AT_KS + AT_VS;
constexpr float AT_THR = 8.0f;
template <int MODE>
__device__ __forceinline__ void attn_phase(const Params& p, LAS unsigned char* lds, int tid, int cidx, bf16* O) {
    asm volatile("" : "+v"(tid));
    const int lane = tid & 63, w = __builtin_amdgcn_readfirstlane(tid >> 6), r32 = lane & 31, hi = lane >> 5;
    const int br = w >> 2, rq = 32 * (w & 3);
    unsigned char* ws = p.ws;
    const bf16* Q = (const bf16*)(ws + WS_ACT); const bf16* Kb = (const bf16*)(ws + WS_KB); const bf16* VT = (const bf16*)(ws + WS_VT);
    unsigned* counter = (unsigned*)(ws + WS_SMALL) + 9 * T + cidx; const float* knmax = (const float*)(ws + WS_SMALL) + 9 * T + 16;
    float lam;
    { float a = p.in[20][lane] * p.in[21][lane], b = p.in[22][lane] * p.in[23][lane]; a = wave_sum(a); b = wave_sum(b); lam = __expf(a) - __expf(b) + LAMBDA_INIT; }
    volatile LAS unsigned* nxt = (volatile LAS unsigned*)(lds + LDS_CTL);
    volatile LAS float* qnw = (volatile LAS float*)(lds + LDS_CTL + 64);
    const int sig = (r32 & ~12) | ((r32 & 4) << 1) | ((r32 & 8) >> 1);
    for (;;) {
        if (tid == 0) *nxt = atomicAdd(counter, 1u);
        __syncthreads();
        const int u = (int)*nxt;
        if (u >= 2048) break;
        int qb, b, h;
        if (u < 512) { qb = 127 - (u >> 2); b = (u >> 1) & 1; h = 7 - (u & 1); }
        else { const int v = u - 512; h = 5 - (v >> 8); qb = 127 - ((v & 255) >> 1); b = v & 1; }
        const int q0 = qb * 128, NT = (q0 + 128) / 64;
        const float slope2 = __builtin_amdgcn_exp2f(-(float)(h + 1)) * LOG2E;
        float so16 = slope2 * 16.0f, so32 = slope2 * 32.0f, so48 = slope2 * 48.0f; asm volatile("" : "+v"(so16), "+v"(so32), "+v"(so48));
        const size_t rowbase = (size_t)b * SEQ;
        bf16x8 qf[4];
        { const bf16* qp = Q + (rowbase + q0 + rq + r32) * 1024 + h * 128 + br * 64 + hi * 8;
#pragma unroll
          for (int d = 0; d < 4; ++d) qf[d] = *(const bf16x8*)(qp + 16 * d); }
        { float s = 0.f;
#pragma unroll
          for (int d = 0; d < 4; ++d)
#pragma unroll
              for (int e = 0; e < 8; ++e) { const float v = __uint_as_float((unsigned)(unsigned short)qf[d][e] << 16); s += v * v; }
          s = swap_sum(s);
#pragma unroll
          for (int o = 1; o < 32; o <<= 1) s = fmaxf(s, __shfl_xor(s, o));
          if (lane == 0) qnw[w] = s; }
        __syncthreads();
        int t0;
        { const float q1 = fmaxf(fmaxf(qnw[0], qnw[1]), fmaxf(qnw[2], qnw[3])), q2 = fmaxf(fmaxf(qnw[4], qnw[5]), fmaxf(qnw[6], qnw[7]));
          const float k1 = knmax[b * 16 + h * 2], k2 = knmax[b * 16 + h * 2 + 1];
          const float bound = 2.0f * sqrtf(fmaxf(q1 * k1, q2 * k2)) * 1.002f + 0.25f;
          const float W = (150.0f + bound) / slope2;
          const float ts = floorf(((float)q0 - W - 63.0f) * (1.0f / 64.0f));
          t0 = ts > 0.f ? (int)ts : 0; if (t0 > NT - 1) t0 = NT - 1;
          t0 = __builtin_amdgcn_readfirstlane(t0); }
        const bf16* kg[2]; const bf16* vg[2]; int kl[2], vl[2];
#pragma unroll
        for (int j = 0; j < 2; ++j) { const int c = tid + 512 * j; const int krow = c >> 4, kcc = c & 15, vrow = c >> 3, vcc = c & 7;
            kg[j] = Kb + (rowbase + krow) * 1024 + h * 128 + kcc * 8; kl[j] = krow * 272 + kcc * 16;
            vg[j] = VT + (size_t)(h * 128 + vrow) * T + rowbase + vcc * 8; vl[j] = AT_KS + vrow * 144 + vcc * 16; }
        u32x4 st[4];
#define AT_LOAD(t) do { _Pragma("unroll") for (int j = 0; j < 2; ++j) { st[j] = *(const u32x4*)(kg[j] + (size_t)(t) * 64 * 1024); st[2 + j] = *(const u32x4*)(vg[j] + (size_t)(t) * 64); } } while (0)
#define AT_STORE(buf) do { _Pragma("unroll") for (int j = 0; j < 2; ++j) { *(LAS u32x4*)(lds + (buf) * AT_STAGE + kl[j]) = st[j]; *(LAS u32x4*)(lds + (buf) * AT_STAGE + vl[j]) = st[2 + j]; } } while (0)
        AT_LOAD(t0); AT_STORE(t0 & 1);
        __syncthreads();
        f32x16 o[4];
#pragma unroll
        for (int d = 0; d < 4; ++d) o[d] = (f32x16){};
        float mu = 0.f, l = 0.f;
        bool first = true;
        const int qpos = q0 + rq + r32;
        for (int t = t0; t < NT; ++t) {
            const int buf = t & 1;
            if (t + 1 < NT) AT_LOAD(t + 1);
            if (64 * t <= q0 + rq + 31) {
                const LAS unsigned char* Kt = lds + buf * AT_STAGE; const LAS unsigned char* Vt = Kt + AT_KS;
                const LAS unsigned char* kp = Kt + sig * 272 + (br * 64 + 8 * hi) * 2; const LAS unsigned char* vp = Vt + r32 * 144 + 16 * hi;
                bf16x8 kf[2][4];
#pragma unroll
                for (int kb = 0; kb < 2; ++kb)
#pragma unroll
                    for (int d = 0; d < 4; ++d) kf[kb][d] = *(const LAS bf16x8*)(kp + kb * (32 * 272) + d * 32);
                const float fb = slope2 * (float)(64 * t - q0 + 8 * hi) - mu;
                f32x16 pr[2];
                { float b8[8];
#pragma unroll
                  for (int j = 0; j < 8; ++j) b8[j] = __builtin_fmaf(slope2, (float)j, fb);
#pragma unroll
                  for (int kb = 0; kb < 2; ++kb)
#pragma unroll
                      for (int r = 0; r < 16; ++r) { const int n16 = 2 * kb + (r >> 3); pr[kb][r] = n16 == 0 ? b8[r & 7] : b8[r & 7] + (n16 == 1 ? so16 : n16 == 2 ? so32 : so48); } }
                __builtin_amdgcn_sched_barrier(0);
                if (!(MODE & 4)) {
#pragma unroll
                for (int d = 0; d < 4; ++d)
#pragma unroll
                    for (int kb = 0; kb < 2; ++kb) pr[kb] = __builtin_amdgcn_mfma_f32_32x32x16_bf16(kf[kb][d], qf[d], pr[kb], 0, 0, 0);
                }
                bf16x8 vf[2][4];
#pragma unroll
                for (int ks = 0; ks < 2; ++ks)
#pragma unroll
                    for (int d = 0; d < 4; ++d) vf[ks][d] = *(const LAS bf16x8*)(vp + d * (32 * 144) + ks * 32);
                __builtin_amdgcn_sched_barrier(0);
                if (!(MODE & 1)) {
                if (64 * t + 63 > q0 + rq) {
                    const int kbase = 64 * t + 8 * hi;
#pragma unroll
                    for (int kb = 0; kb < 2; ++kb)
#pragma unroll
                        for (int r = 0; r < 16; ++r) if (kbase + 32 * kb + 16 * (r >> 3) + (r & 7) > qpos) pr[kb][r] = -INFINITY;
                }
                float mx;
                { float m8[8];
#pragma unroll
                  for (int j = 0; j < 4; ++j) { m8[j] = __builtin_fmaxf(__builtin_fmaxf(pr[0][4 * j], pr[0][4 * j + 1]), pr[0][4 * j + 2]); m8[4 + j] = __builtin_fmaxf(__builtin_fmaxf(pr[1][4 * j], pr[1][4 * j + 1]), pr[1][4 * j + 2]); }
#pragma unroll
                  for (int j = 0; j < 4; ++j) { m8[j] = __builtin_fmaxf(__builtin_fmaxf(m8[j], pr[0][4 * j + 3]), pr[1][4 * j + 3]); }
                  const float ma = __builtin_fmaxf(__builtin_fmaxf(m8[0], m8[1]), m8[2]), mb = __builtin_fmaxf(__builtin_fmaxf(m8[3], m8[4]), m8[5]);
                  mx = __builtin_fmaxf(__builtin_fmaxf(ma, mb), __builtin_fmaxf(m8[6], m8[7])); }
                mx = swap_max(mx);
                if (first || __any(mx > AT_THR)) {
                    const float dl = first ? mx : fmaxf(mx, 0.f); const float alpha = first ? 1.0f : __builtin_amdgcn_exp2f(-dl);
                    mu += dl; l *= alpha;
#pragma unroll
                    for (int kb = 0; kb < 2; ++kb)
#pragma unroll
                        for (int r = 0; r < 16; ++r) pr[kb][r] -= dl;
#pragma unroll
                    for (int d = 0; d < 4; ++d)
#pragma unroll
                        for (int r = 0; r < 16; ++r) o[d][r] *= alpha;
                    first = false;
                }
                }
                float rs4[4] = {0.f, 0.f, 0.f, 0.f};
                bf16x8 pw[4];
#pragma unroll
                for (int ks = 0; ks < 4; ++ks) { const int kb = ks >> 1, r0 = 8 * (ks & 1);
#pragma unroll
                    for (int r = r0; r < r0 + 8; ++r) { if (!(MODE & 1)) { const float e = __builtin_amdgcn_exp2f(pr[kb][r]); pr[kb][r] = e; rs4[r & 3] += e; } }
                    u32x4 t4; t4.x = pg8::cvt_pk_bf16(pr[kb][r0], pr[kb][r0 + 1]); t4.y = pg8::cvt_pk_bf16(pr[kb][r0 + 2], pr[kb][r0 + 3]); t4.z = pg8::cvt_pk_bf16(pr[kb][r0 + 4], pr[kb][r0 + 5]); t4.w = pg8::cvt_pk_bf16(pr[kb][r0 + 6], pr[kb][r0 + 7]);
                    pw[ks] = __builtin_bit_cast(bf16x8, t4); }
                l += (rs4[0] + rs4[1]) + (rs4[2] + rs4[3]);
                __builtin_amdgcn_sched_barrier(0);
#pragma unroll
                for (int ks = 0; ks < 2; ++ks)
#pragma unroll
                    for (int d = 0; d < 4; ++d) { if (!(MODE & 2)) o[d] = __builtin_amdgcn_mfma_f32_32x32x16_bf16(vf[ks][d], pw[ks], o[d], 0, 0, 0); }
#pragma unroll
                for (int ks = 0; ks < 2; ++ks)
#pragma unroll
                    for (int d = 0; d < 4; ++d) vf[ks][d] = *(const LAS bf16x8*)(vp + d * (32 * 144) + (ks + 2) * 32);
                __builtin_amdgcn_sched_barrier(0);
#pragma unroll
                for (int ks = 0; ks < 2; ++ks)
#pragma unroll
                    for (int d = 0; d < 4; ++d) { if (!(MODE & 2)) o[d] = __builtin_amdgcn_mfma_f32_32x32x16_bf16(vf[ks][d], pw[ks + 2], o[d], 0, 0, 0); }
            }
            if (t + 1 < NT) AT_STORE(buf ^ 1);
            __syncthreads();
        }
#undef AT_LOAD
#undef AT_STORE
        const float lt = swap_sum(l), inv = 1.0f / lt;
        LAS float* X = (LAS float*)lds;
        if (br == 1) { const float sc = inv * lam;
#pragma unroll
            for (int d = 0; d < 4; ++d)
#pragma unroll
                for (int r = 0; r < 16; ++r) X[((w & 3) * 64 + d * 16 + r) * 64 + lane] = o[d][r] * sc; }
        __syncthreads();
        if (br == 0) { float ss = 0.f;
#pragma unroll
            for (int d = 0; d < 4; ++d)
#pragma unroll
                for (int r = 0; r < 16; ++r) { const float v = o[d][r] * inv - X[((w & 3) * 64 + d * 16 + r) * 64 + lane]; o[d][r] = v; ss += v * v; }
            ss = swap_sum(ss);
            const float rn = __builtin_amdgcn_rsqf(ss * (1.0f / 128.0f) + 1e-6f);
            bf16* op = O + (rowbase + qpos) * 1024 + h * 128 + 4 * hi;
#pragma unroll
            for (int d = 0; d < 4; ++d)
#pragma unroll
                for (int g4 = 0; g4 < 4; ++g4) { u32x2 wv; wv.x = pg8::cvt_pk_bf16(o[d][4 * g4] * rn, o[d][4 * g4 + 1] * rn); wv.y = pg8::cvt_pk_bf16(o[d][4 * g4 + 2] * rn, o[d][4 * g4 + 3] * rn);
                    *(u32x2*)(op + 32 * d + 8 * g4) = wv; } }
        __syncthreads();
    }
}

__device__ __forceinline__ void final_phase(const Params& p, int G, int bid, int tid) {
    asm volatile("" : "+v"(tid)); asm volatile("" : "+s"(G), "+s"(bid));
    const int lane = tid & 63, wave = tid >> 6; const int gw = bid * 8 + wave, NGW = G * 8;
    const float* ssq = (const float*)(p.ws + WS_SMALL) + 6 * T; const f32x4* gp = (const f32x4*)p.in[26] + lane;
    const bf16* xh = (const bf16*)(p.ws + WS_XB);
    f32x4 gv[4];
#pragma unroll
    for (int j = 0; j < 4; ++j) gv[j] = gp[64 * j];
#pragma unroll 1
    for (int m = gw; m < T; m += NGW) { f32x4* orow = (f32x4*)(p.out + (size_t)m * D) + lane; const float rs = pg8::rstd_row(ssq, m);
        const u32x2* hrow = (const u32x2*)(xh + (size_t)m * D) + lane; const u32x2* lrow = (const u32x2*)((const bf16*)p.out + (size_t)m * 2048 + 1024) + lane;
        u32x2 hv[4], lv[4];
#pragma unroll
        for (int j = 0; j < 4; ++j) { hv[j] = hrow[64 * j]; lv[j] = lrow[64 * j]; }
        asm volatile("s_waitcnt vmcnt(0)" ::: "memory");
#pragma unroll
        for (int j = 0; j < 4; ++j) { f32x4 v;
            v[0] = __uint_as_float(hv[j].x << 16) + __uint_as_float(lv[j].x << 16); v[1] = __uint_as_float(hv[j].x & 0xffff0000u) + __uint_as_float(lv[j].x & 0xffff0000u);
            v[2] = __uint_as_float(hv[j].y << 16) + __uint_as_float(lv[j].y << 16); v[3] = __uint_as_float(hv[j].y & 0xffff0000u) + __uint_as_float(lv[j].y & 0xffff0000u);
            orow[64 * j] = v * rs * gv[j]; } }
}

__global__ void __launch_bounds__(512) yoco_fwd(Params p) {
    extern __shared__ __attribute__((aligned(16))) unsigned char lds_raw[];
    cg::grid_group grid = cg::this_grid();
    LAS unsigned char* lds = (LAS unsigned char*)lds_raw;
    const int tid = threadIdx.x, bid = blockIdx.x, G = gridDim.x;
    unsigned char* ws = p.ws;
    float* small = (float*)(ws + WS_SMALL);
    bf16* xb = (bf16*)(ws + WS_XB); bf16* act = (bf16*)(ws + WS_ACT); bf16* kbuf = (bf16*)(ws + WS_KB); bf16* vt = (bf16*)(ws + WS_VT);
    volatile LAS unsigned* xb_st = (volatile LAS unsigned*)(lds + LDS_CTL + 128);
    if (tid == 0) { xb_st[0] = 0u; xb_st[1] = 0u; }
    __syncthreads();
    XcdBarrier xbar = xcd_barrier_post((unsigned*)(ws + WS_XBAR), xb_st);
    if (p.ws == nullptr) grid.sync();
#pragma unroll 1
    for (int ph = 0; ph < 16; ++ph) {
        if (ph == 0) prologue(p, lds, G, bid, tid);
        if (ph == 10) knorm_pass(p, G, bid, tid);
        if (ph == 8 || ph == 10) {
            const bool isq = ph == 10;
            pg8::Gemm g{xb, (const bf16*)(ws + (isq ? WS_WQ : WS_WK)), T, D, D}; pg8::StaticOrder S; S.init(T, D, G, bid);
            pg8::EpiScale E{isq ? act : kbuf, small + (isq ? 4 : 3) * T, isq ? QSCALE : 1.0f};
            pg8::gemm_phase<pg8::EpiScale, pg8::StaticOrder, true, true>(lds, g, S, E);
        }
        if (ph == 8) {
            pg8::Gemm g{(const bf16*)(ws + WS_WV), xb, D, T, D}; pg8::StaticOrder S; S.init(D, T, G, bid);
            pg8::EpiScaleCol E{vt, small + 3 * T, T};
            pg8::gemm_phase<pg8::EpiScaleCol, pg8::StaticOrder, true, true>(lds, g, S, E);
        }
        if (ph == 1 || ph == 6 || ph == 8 || ph == 13) {
            const int f = ph == 1 ? 0 : ph == 6 ? 1 : ph == 8 ? 2 : 3, si = ph == 1 ? 0 : ph == 6 ? 2 : ph == 8 ? 3 : 5;
            pg8::Gemm g{xb, (const bf16*)(ws + WS_WGU + f * WGU_BYTES), T, 2 * FF, D}; pg8::StaticOrder S; S.init(T, 2 * FF, G, bid);
            pg8::EpiSwiGLU E{act, small + si * T};
            pg8::gemm_phase<pg8::EpiSwiGLU, pg8::StaticOrder, true, true>(lds, g, S, E);
        }
        if (ph == 2 || ph == 7 || ph == 9 || ph == 14 || ph == 5 || ph == 12) {
            const bf16* A; const bf16* B; int K; float coef; int so;
            if (ph == 5)       { A = kbuf; B = (const bf16*)(ws + WS_WOUT); K = D; coef = 1.f; so = 2; }
            else if (ph == 12) { A = (const bf16*)(ws + WS_ACT + 64 * MiB); B = (const bf16*)(ws + WS_WO); K = D; coef = 1.f; so = 5; }
            else { const int f = ph == 2 ? 0 : ph == 7 ? 1 : ph == 9 ? 2 : 3; A = act; B = (const bf16*)(ws + WS_WDN + f * WDN_BYTES); K = FF; coef = 0.5f; so = ph == 2 ? 1 : ph == 7 ? 3 : ph == 9 ? 4 : 6; }
            pg8::Gemm g{A, B, T, D, K}; pg8::StaticOrder S; S.init(T, D, G, bid);
            pg8::EpiResid E{ph == 2 ? p.in[0] : nullptr, xb, (bf16*)p.out + 1024, small + so * T, coef};
            pg8::gemm_phase<pg8::EpiResid, pg8::StaticOrder, true, true>(lds, g, S, E);
        }
        if (ph == 3) {
            pg8::Gemm g{xb, (const bf16*)(ws + WS_WIN), T, 2 * D, D}; pg8::StaticOrder S; S.init(T, 2 * D, G, bid);
            pg8::EpiGeluZ E{act, small + 1 * T, small + 7 * T, small + 8 * T};
            pg8::gemm_phase<pg8::EpiGeluZ, pg8::StaticOrder, true, true>(lds, g, S, E);
        }
        if (ph == 4) spatial_phase(p, lds, G, bid, tid);
        if (ph == 11) attn_phase<0>(p, lds, tid, 0, (bf16*)(ws + WS_ACT + 64 * MiB));
        if (ph == 15) final_phase(p, G, bid, tid);
        if (ph < 15) xcd_barrier(xbar);
    }
}

extern "C" void kernel_launch(void* const* d_in, const int* in_sizes, int n_in, void* d_out, int out_size, void* d_ws, size_t ws_size, hipStream_t stream) {
    static int grid = 0;
    if (grid == 0) {
        if (n_in != 27 || in_sizes[0] != T * D || out_size != T * D || ws_size < WS_END) { fprintf(stderr, "kernel_launch: unexpected shapes (n_in %d, in0 %d, out %d, ws %zu); nothing launched\n", n_in, n_in > 0 ? in_sizes[0] : -1, out_size, ws_size); grid = -1; return; }
        int dev = 0, cus = 0, per_cu = 0;
        hipGetDevice(&dev); hipDeviceGetAttribute(&cus, hipDeviceAttributeMultiprocessorCount, dev);
        hipFuncSetAttribute((const void*)yoco_fwd, hipFuncAttributeMaxDynamicSharedMemorySize, LDS_BYTES);
        hipOccupancyMaxActiveBlocksPerMultiprocessor(&per_cu, (const void*)yoco_fwd, 512, LDS_BYTES);
        (void)hipGetLastError();
        if (per_cu < 1) per_cu = 1;
        grid = cus * 1;
        if (grid <= 0) grid = 256;
    }
    if (grid < 0) return;
    (void)hipMemsetAsync((unsigned char*)d_ws + WS_XBAR, 0, XCD_BAR_WORDS * 4, stream);
    Params p{};
    for (int i = 0; i < 27; ++i) p.in[i] = (const float*)d_in[i];
    p.out = (float*)d_out; p.ws = (unsigned char*)d_ws;
    void* args[] = {&p};
    hipError_t e = hipLaunchCooperativeKernel((const void*)yoco_fwd, dim3(grid), dim3(512), args, LDS_BYTES, stream);
    if (e != hipSuccess) fprintf(stderr, "cooperative launch failed: %s (grid %d)\n", hipGetErrorString(e), grid);
}
```
